# Optimizing an MI355X kernel written in HIP

```python
import math
import jax, jax.numpy as jnp
from jax import lax
import numpy as np

D_MODEL = 2048
BATCH = 4
SEQ = 2048
DEPTH = 2

GRID_W = 64
CTX_LEN = 256
HEAD_DIM = 128
NA_HEADS = 6
MLA_HEADS = 5
RET_HEADS = 5
NA_WIDTH = NA_HEADS * HEAD_DIM
MLA_WIDTH = MLA_HEADS * HEAD_DIM
RET_WIDTH = RET_HEADS * HEAD_DIM
MIX_WIDTH = NA_WIDTH + MLA_WIDTH + RET_WIDTH
NA_WIN_R = 8
NA_WIN_C = 16
NA_QB = 16
NA_BAND = 2 * NA_WIN_C
MLA_Q_RANK = 512
MLA_KV_RANK = 512
MLA_NOPE = 128
MLA_ROPE = 64
MLA_V = 128
RET_CHUNK = 128
RET_DK = HEAD_DIM
D_FF = 5632
CONV_W = 3
ROPE_BASE = 10000.0
Q_BLOCK = 128
LN_EPS = 1e-5
RMS_EPS = 1e-6
NEG_INF = -1e30
DEEPNORM_ALPHA = (2 * DEPTH) ** 0.25
DEEPNORM_BETA = (8 * DEPTH) ** -0.25
IN_SPLITS = (NA_WIDTH, NA_WIDTH, NA_WIDTH, MLA_Q_RANK, MLA_KV_RANK, MLA_ROPE, RET_WIDTH, RET_WIDTH, RET_WIDTH, RET_WIDTH)
IN_WIDTH = sum(IN_SPLITS)

kernel_name = "hybrid_na_mla_retention_dit_trunk"


def layer_norm(x, g, b):
    xf = x.astype(jnp.float32)
    mu = xf.mean(-1, keepdims=True)
    var = jnp.square(xf - mu).mean(-1, keepdims=True)
    return ((xf - mu) * lax.rsqrt(var + LN_EPS) * g + b).astype(x.dtype)


def rms_norm(x, g):
    xf = x.astype(jnp.float32)
    return (xf * lax.rsqrt(jnp.square(xf).mean(-1, keepdims=True) + RMS_EPS) * g).astype(x.dtype)


def head_norm(x):
    xf = x.astype(jnp.float32)
    mu = xf.mean(-1, keepdims=True)
    var = jnp.square(xf - mu).mean(-1, keepdims=True)
    return ((xf - mu) * lax.rsqrt(var + LN_EPS)).astype(x.dtype)


def modulate(x, shift, scale):
    return x * (1.0 + scale) + shift


def split_heads(a, h):
    return a.reshape(a.shape[:-1] + (h, a.shape[-1] // h))


def split_cols(p):
    return jnp.split(p, [int(i) for i in np.cumsum(IN_SPLITS)[:-1]], axis=-1)


def axial_rope_tables(T, rot_dim):
    t = jnp.arange(T)
    row = (t // GRID_W).astype(jnp.float32)
    col = (t % GRID_W).astype(jnp.float32)
    nf = rot_dim // 4
    inv = ROPE_BASE ** (-jnp.arange(nf, dtype=jnp.float32) / nf)
    ar = row[:, None] * inv[None]
    ac = col[:, None] * inv[None]
    ang = jnp.concatenate([ar, ar, ac, ac], -1)
    return jnp.cos(ang), jnp.sin(ang)


def apply_rope(x, cos, sin):
    shape = (x.shape[1],) + (1,) * (x.ndim - 3) + (x.shape[-1],)
    cos = cos.reshape(shape)
    sin = sin.reshape(shape)
    half = x.shape[-1] // 2
    nf = half // 2

    def rot_half(y):
        return jnp.concatenate([-y[..., nf:], y[..., :nf]], -1)

    x_rot = jnp.concatenate([rot_half(x[..., :half]), rot_half(x[..., half:])], -1)
    return (x * cos + x_rot * sin).astype(x.dtype)


def dense_attention(q, k, v):
    B, Tq, H, dk = q.shape
    nb = Tq // Q_BLOCK
    scale = dk ** -0.5
    qb = q.reshape(B, nb, Q_BLOCK, H, dk).transpose(1, 0, 2, 3, 4)

    def block(q_blk):
        s = jnp.einsum('bqhd,bkhd->bhqk', q_blk, k).astype(jnp.float32) * scale
        p = jax.nn.softmax(s, axis=-1).astype(v.dtype)
        return jnp.einsum('bhqk,bkhd->bqhd', p, v)

    out = lax.map(block, qb)
    return out.transpose(1, 0, 2, 3, 4).reshape(B, Tq, H, v.shape[-1])


def neighborhood_attention(q, k, v, kc, vc, rpb):
    B, T, H, d = q.shape
    rows = T // GRID_W
    kr = min(NA_WIN_R, rows)
    ncb = GRID_W // NA_QB
    scale = d ** -0.5
    q_col = np.arange(GRID_W).reshape(ncb, NA_QB)
    col_start = np.clip(q_col - NA_WIN_C // 2, 0, GRID_W - NA_WIN_C)
    band_start = np.minimum(col_start[:, 0], GRID_W - NA_BAND)
    key_col = band_start[:, None] + np.arange(NA_BAND)[None]
    in_win = (key_col[:, None, :] >= col_start[..., None]) & (key_col[:, None, :] < col_start[..., None] + NA_WIN_C)
    dc_idx = np.clip(key_col[:, None, :] - q_col[..., None] + NA_WIN_C - 1, 0, 2 * NA_WIN_C - 2)
    mask = in_win[:, :, None, :]
    kg = k.reshape(B, rows, GRID_W, H, d)
    vg = v.reshape(B, rows, GRID_W, H, d)
    qg = q.reshape(B, rows, ncb, NA_QB, H, d).transpose(1, 0, 2, 3, 4, 5)
    n_loc = kr * NA_BAND

    def row_block(args):
        r, q_r = args
        r0 = jnp.clip(r - kr // 2, 0, rows - kr)
        k_r = lax.dynamic_slice_in_dim(kg, r0, kr, axis=1)[:, :, key_col]
        v_r = lax.dynamic_slice_in_dim(vg, r0, kr, axis=1)[:, :, key_col]
        dr_idx = r0 + jnp.arange(kr) - r + NA_WIN_R - 1
        bias = rpb[:, dr_idx[None, None, :, None], dc_idx[:, :, None, :]]
        s_loc = jnp.einsum('bjqhd,bkjchd->bhjqkc', q_r, k_r).astype(jnp.float32) * scale + bias.astype(jnp.float32)
        s_loc = jnp.where(mask, s_loc, NEG_INF)
        s_ctx = jnp.einsum('bjqhd,bnhd->bhjqn', q_r, kc).astype(jnp.float32) * scale
        s = jnp.concatenate([s_loc.reshape(B, H, ncb, NA_QB, n_loc), s_ctx], -1)
        p = jax.nn.softmax(s, axis=-1).astype(v.dtype)
        p_loc = p[..., :n_loc].reshape(B, H, ncb, NA_QB, kr, NA_BAND)
        out = jnp.einsum('bhjqkc,bkjchd->bjqhd', p_loc, v_r) + jnp.einsum('bhjqn,bnhd->bjqhd', p[..., n_loc:], vc)
        return out.reshape(B, GRID_W, H, d)

    out = lax.map(row_block, (jnp.arange(rows), qg))
    return out.transpose(1, 0, 2, 3, 4).reshape(B, T, H, d)


def mla_q(cq, g_q, w_uq, rope):
    q = split_heads(rms_norm(cq, g_q) @ w_uq, MLA_HEADS)
    q_nope, q_pe = q[..., :MLA_NOPE], q[..., MLA_NOPE:]
    if rope is not None:
        q_pe = apply_rope(q_pe, *rope)
    return jnp.concatenate([q_nope, q_pe], -1)


def mla_kv(ckv, kpe, g_kv, w_ukv, rope):
    kv = split_heads(rms_norm(ckv, g_kv) @ w_ukv, MLA_HEADS)
    k_nope, v = kv[..., :MLA_NOPE], kv[..., MLA_NOPE:]
    if rope is not None:
        kpe = apply_rope(kpe, *rope)
    kpe = jnp.broadcast_to(kpe[:, :, None, :], k_nope.shape[:-1] + (MLA_ROPE,))
    return jnp.concatenate([k_nope, kpe], -1), v


def retention_chunked(q, k, v, log_gamma, s0):
    B, T, H, _ = q.shape
    dv = v.shape[-1]
    L = RET_CHUNK
    n = T // L

    def chunks(a):
        return a.astype(jnp.float32).reshape(B, n, L, H, a.shape[-1]).transpose(1, 0, 3, 2, 4)

    pos = jnp.arange(L, dtype=jnp.float32)
    diff = pos[:, None] - pos[None, :]
    decay = jnp.where(diff >= 0, jnp.exp(jnp.maximum(diff, 0.0)[None] * log_gamma[:, None, None]), 0.0)
    q_dec = jnp.exp((pos + 1.0)[None] * log_gamma[:, None])[:, :, None]
    k_dec = jnp.exp((L - 1.0 - pos)[None] * log_gamma[:, None])[:, :, None]
    chunk_dec = jnp.exp(L * log_gamma)[:, None, None]

    def step(state, qkv):
        qi, ki, vi = qkv
        inner = jnp.einsum('bhlm,bhme->bhle', jnp.einsum('bhld,bhmd->bhlm', qi, ki) * decay, vi)
        cross = jnp.einsum('bhld,bhde->bhle', qi * q_dec, state)
        state = chunk_dec * state + jnp.einsum('bhld,bhle->bhde', ki * k_dec, vi)
        return state, inner + cross

    _, out = lax.scan(step, s0.astype(jnp.float32), (chunks(q), chunks(k), chunks(v)))
    return out.transpose(1, 0, 3, 2, 4).reshape(B, T, H, dv).astype(v.dtype)


def retention_final_state(k, v, log_gamma, reverse):
    C = k.shape[1]
    pos = jnp.arange(C, dtype=jnp.float32)
    steps = pos if reverse else (C - 1.0 - pos)
    w = jnp.exp(steps[None, :] * log_gamma[:, None])
    return jnp.einsum('bmhd,bmhe,hm->bhde', k.astype(jnp.float32), v.astype(jnp.float32), w)


def bidir_retention(q, k, v, lg_f, lg_b, s_f, s_b):
    flip = lambda a: jnp.flip(a, axis=1)
    o_f = retention_chunked(q, k, v, lg_f, s_f)
    o_b = flip(retention_chunked(flip(q), flip(k), flip(v), lg_b, s_b))
    return o_f + o_b


def conv_glu(h, w_up, conv_w, conv_b, w_down):
    T = h.shape[1]
    a, u = jnp.split(h @ w_up, 2, axis=-1)
    pad = CONV_W // 2
    ap = jnp.pad(a, ((0, 0), (pad, pad), (0, 0)))
    acc = conv_b
    for i in range(CONV_W):
        acc = acc + ap[:, i:i + T] * conv_w[i]
    return (jax.nn.silu(acc) * u) @ w_down


def setup_inputs(seed: int = 0) -> dict:
    key = jax.random.key(seed)
    ks = jax.random.split(key, 24)
    f32 = jnp.float32
    D = D_MODEL

    def normal(k, shape, scale):
        return jax.random.normal(k, shape, f32) * scale

    return {
        "x": normal(ks[0], (BATCH, SEQ, D), 1.0),
        "c": normal(ks[1], (BATCH, D), 1.0),
        "ctx": normal(ks[2], (BATCH, CTX_LEN, D), 1.0),
        "c_ctx": normal(ks[3], (D,), 1.0),
        "w_ada": normal(ks[4], (DEPTH, D, 6 * D), 0.5 * D ** -0.5),
        "b_ada": normal(ks[5], (DEPTH, 6 * D), 0.02),
        "w_in": normal(ks[6], (DEPTH, D, IN_WIDTH), D ** -0.5),
        "mla_q_norm": 1.0 + normal(ks[7], (DEPTH, MLA_Q_RANK), 0.02),
        "mla_kv_norm": 1.0 + normal(ks[8], (DEPTH, MLA_KV_RANK), 0.02),
        "w_uq": normal(ks[9], (DEPTH, MLA_Q_RANK, MLA_HEADS * (MLA_NOPE + MLA_ROPE)), MLA_Q_RANK ** -0.5),
        "w_ukv": normal(ks[10], (DEPTH, MLA_KV_RANK, MLA_HEADS * (MLA_NOPE + MLA_V)), MLA_KV_RANK ** -0.5),
        "na_rpb": normal(ks[11], (DEPTH, NA_HEADS, 2 * NA_WIN_R - 1, 2 * NA_WIN_C - 1), 0.02),
        "ret_decay": -5.0 - jnp.arange(RET_HEADS, dtype=f32) + normal(ks[12], (DEPTH, 2, RET_HEADS), 0.1),
        "w_o": normal(ks[13], (DEPTH, MIX_WIDTH, D), DEEPNORM_BETA * MIX_WIDTH ** -0.5),
        "ln1_g": 1.0 + normal(ks[14], (DEPTH, D), 0.02),
        "ln1_b": normal(ks[15], (DEPTH, D), 0.02),
        "w_up": normal(ks[16], (DEPTH, D, 2 * D_FF), D ** -0.5),
        "conv_w": normal(ks[17], (DEPTH, CONV_W, D_FF), CONV_W ** -0.5),
        "conv_b": normal(ks[18], (DEPTH, D_FF), 0.02),
        "w_down": normal(ks[19], (DEPTH, D_FF, D), DEEPNORM_BETA * D_FF ** -0.5),
        "ln2_g": 1.0 + normal(ks[20], (DEPTH, D), 0.02),
        "ln2_b": normal(ks[21], (DEPTH, D), 0.02),
    }


def reference(x, c, ctx, c_ctx, w_ada, b_ada, w_in, mla_q_norm, mla_kv_norm, w_uq, w_ukv, na_rpb, ret_decay,
              w_o, ln1_g, ln1_b, w_up, conv_w, conv_b, w_down, ln2_g, ln2_b):
    B, T, _ = x.shape
    rope_pe = axial_rope_tables(T, MLA_ROPE)
    rope_ret = axial_rope_tables(T, RET_DK)
    silu_c = jax.nn.silu(c)
    silu_cc = jax.nn.silu(c_ctx)
    ret_scale = RET_DK ** -0.5
    for l in range(DEPTH):
        last = l == DEPTH - 1
        mod = (silu_c @ w_ada[l] + b_ada[l])[:, None, :]
        mod_c = silu_cc @ w_ada[l] + b_ada[l]
        sh1, sc1, g1, sh2, sc2, g2 = jnp.split(mod, 6, axis=-1)
        csh1, csc1, cg1, csh2, csc2, cg2 = jnp.split(mod_c, 6, axis=-1)

        na_q, na_k, na_v, cq, ckv, kpe, r_q, r_k, r_v, r_g = split_cols(modulate(x, sh1, sc1) @ w_in[l])
        na_qc, na_kc, na_vc, cq_c, ckv_c, kpe_c, r_qc, r_kc, r_vc, r_gc = split_cols(modulate(ctx, csh1, csc1) @ w_in[l])

        kc_na = split_heads(na_kc, NA_HEADS)
        vc_na = split_heads(na_vc, NA_HEADS)
        y_na = neighborhood_attention(split_heads(na_q, NA_HEADS), split_heads(na_k, NA_HEADS),
                                      split_heads(na_v, NA_HEADS), kc_na, vc_na, na_rpb[l])

        k_mc, v_mc = mla_kv(ckv_c, kpe_c, mla_kv_norm[l], w_ukv[l], None)
        k_ml, v_ml = mla_kv(ckv, kpe, mla_kv_norm[l], w_ukv[l], rope_pe)
        q_ml = mla_q(cq, mla_q_norm[l], w_uq[l], rope_pe)
        y_mla = dense_attention(q_ml, jnp.concatenate([k_mc, k_ml], 1), jnp.concatenate([v_mc, v_ml], 1))

        lg = jnp.log1p(-jnp.exp2(ret_decay[l].astype(jnp.float32)))
        lg_f, lg_b = lg[0], lg[1]
        kc_r = split_heads(r_kc, RET_HEADS) * ret_scale
        vc_r = split_heads(r_vc, RET_HEADS)
        s_f = retention_final_state(kc_r, vc_r, lg_f, reverse=False)
        s_b = retention_final_state(kc_r, vc_r, lg_b, reverse=True)
        q_r = apply_rope(split_heads(r_q, RET_HEADS), *rope_ret)
        k_r = apply_rope(split_heads(r_k, RET_HEADS), *rope_ret) * ret_scale
        o_r = bidir_retention(q_r, k_r, split_heads(r_v, RET_HEADS), lg_f, lg_b, s_f, s_b)
        y_ret = head_norm(o_r) * jax.nn.silu(split_heads(r_g, RET_HEADS))

        y = jnp.concatenate([y_na.reshape(B, T, NA_WIDTH), y_mla.reshape(B, T, MLA_WIDTH),
                             y_ret.reshape(B, T, RET_WIDTH)], -1) @ w_o[l]
        x_new = layer_norm(DEEPNORM_ALPHA * x + g1 * y, ln1_g[l], ln1_b[l])

        if not last:
            Bc, C, _ = ctx.shape
            yc_na = dense_attention(split_heads(na_qc, NA_HEADS), kc_na, vc_na)
            yc_mla = dense_attention(mla_q(cq_c, mla_q_norm[l], w_uq[l], None), k_mc, v_mc)
            zero_state = jnp.zeros((Bc, RET_HEADS, RET_DK, HEAD_DIM), jnp.float32)
            oc_r = bidir_retention(split_heads(r_qc, RET_HEADS), kc_r, vc_r, lg_f, lg_b, zero_state, zero_state)
            yc_ret = head_norm(oc_r) * jax.nn.silu(split_heads(r_gc, RET_HEADS))
            yc = jnp.concatenate([yc_na.reshape(Bc, C, NA_WIDTH), yc_mla.reshape(Bc, C, MLA_WIDTH),
                                  yc_ret.reshape(Bc, C, RET_WIDTH)], -1) @ w_o[l]
            ctx = layer_norm(DEEPNORM_ALPHA * ctx + cg1 * yc, ln1_g[l], ln1_b[l])
        x = x_new

        yf = conv_glu(modulate(x, sh2, sc2), w_up[l], conv_w[l], conv_b[l], w_down[l])
        x = layer_norm(DEEPNORM_ALPHA * x + g2 * yf, ln2_g[l], ln2_b[l])
        if not last:
            ycf = conv_glu(modulate(ctx, csh2, csc2), w_up[l], conv_w[l], conv_b[l], w_down[l])
            ctx = layer_norm(DEEPNORM_ALPHA * ctx + cg2 * ycf, ln2_g[l], ln2_b[l])
    return x
```

```cpp
#include <hip/hip_runtime.h>
#include <hip/hip_cooperative_groups.h>
#include <cstdio>
namespace cg = cooperative_groups;

#define LAS __attribute__((address_space(3)))
#define DI __device__ __forceinline__
typedef unsigned short bf16_t;
typedef short bf16x8 __attribute__((ext_vector_type(8)));
typedef float f32x4 __attribute__((ext_vector_type(4)));
typedef float f32x2 __attribute__((ext_vector_type(2)));
typedef unsigned u32x2 __attribute__((ext_vector_type(2)));
typedef unsigned u32x4 __attribute__((ext_vector_type(4)));

constexpr int DM = 2048, TL = 2048, CL = 256, RB = 2304, MR = 9216;
constexpr int INW = 5952, INP = 6144, DFF = 5632;
constexpr int C_NAQ = 0, C_NAK = 768, C_NAV = 1536, C_CQ = 2304, C_CKV = 2816, C_KPE = 3328, C_RQ = 3392, C_RK = 4032, C_RV = 4672, C_RG = 5312;
constexpr float ALPHA = 1.4142135623730951f;

constexpr size_t al(size_t x) { return (x + 255) & ~(size_t)255; }
constexpr size_t WS_CTL = 0;
constexpr size_t CTL_BYTES = 32768;
constexpr size_t WS_QCTR = 16384;
constexpr size_t WS_MOD = CTL_BYTES;
constexpr size_t WS_TABM = al(WS_MOD + 2ull * 5 * 12288 * 4);
constexpr size_t WS_TABR = al(WS_TABM + 2048ull * 32 * 8);
constexpr size_t WS_SSQ = al(WS_TABR + 2048ull * 64 * 8);
constexpr size_t WS_WIN = al(WS_SSQ + 9216ull * 32 * 4);
constexpr size_t WS_WUQ = al(WS_WIN + 2ull * 6144 * 2048 * 2);
constexpr size_t WS_WUKV = al(WS_WUQ + 2ull * 1024 * 512 * 2);
constexpr size_t WS_WO = al(WS_WUKV + 2ull * 1280 * 512 * 2);
constexpr size_t WS_WUP = al(WS_WO + 2ull * 2048 * 2048 * 2);
constexpr size_t WS_WDN = al(WS_WUP + 2ull * 11264 * 2048 * 2);
constexpr size_t WS_X = al(WS_WDN + 2ull * 2048 * 5632 * 2);
constexpr size_t WS_AU = al(WS_X + 9216ull * 2048 * 4);
constexpr size_t WS_G = al(WS_AU + 9216ull * 11264 * 2);
constexpr size_t WS_H = al(WS_G + 9216ull * 5632 * 2);
constexpr size_t WS_RSTAT = al(WS_H + 9216ull * 2048 * 2);
constexpr size_t WS_END = al(WS_RSTAT + 9216ull * 8);
constexpr size_t WS_EDGE = WS_AU;
constexpr size_t WS_PART = WS_AU + (16ull << 20);
constexpr size_t WS_P = WS_AU;
constexpr size_t WS_VTNA = al(WS_P + 9216ull * 6144 * 2);
constexpr size_t WS_VTR = al(WS_VTNA + 4ull * 768 * 2304 * 2);
constexpr size_t WS_KTR = al(WS_VTR + 4ull * 640 * 2304 * 2);
constexpr size_t WS_QM = al(WS_KTR + 4ull * 640 * 2304 * 2);
constexpr size_t WS_KM = al(WS_QM + 9216ull * 960 * 2);
constexpr size_t WS_VTM = al(WS_KM + 9216ull * 640 * 2);
constexpr size_t WS_KPE = al(WS_VTM + 4ull * 640 * 2304 * 2);
constexpr size_t WS_KTRB = al(WS_KPE + 9216ull * 64 * 2);
static_assert(al(WS_KTRB + 4ull * 640 * 2304 * 2) <= WS_G, "mixer scratch must fit under AU");
constexpr size_t WS_YMIX = WS_G;
constexpr size_t WS_S = al(WS_YMIX + 9216ull * 2048 * 2);
static_assert(al(WS_S + 4ull * 5 * 2 * 18 * 128 * 128 * 2) <= WS_H, "G region too small");

constexpr int LDS_CTRL = 139264;
constexpr int LDS_BYTES = LDS_CTRL + 1024;

struct Params { const float* in[22]; float* out; unsigned char* ws; int ph_lo, ph_hi; };

DI bf16_t f2bf(float x) { unsigned u = __float_as_uint(x); u += 0x7fffu + ((u >> 16) & 1u); return (bf16_t)(u >> 16); }
DI float bf2f(bf16_t h) { return __uint_as_float(((unsigned)h) << 16); }
DI unsigned cvt_pk_bf16(float lo, float hi) { unsigned r; asm volatile("v_cvt_pk_bf16_f32 %0, %1, %2" : "=v"(r) : "v"(lo), "v"(hi)); return r; }
DI float wave_sum(float v) {
#pragma unroll
    for (int o = 32; o > 0; o >>= 1) v += __shfl_xor(v, o);
    return v;
}
DI int otid() { int t = threadIdx.x; asm volatile("" : "+v"(t)); return t; }
DI float silu(float v) { return v * __builtin_amdgcn_rcpf(1.f + __builtin_amdgcn_exp2f(-1.4426950408889634f * v)); }

#define XB_TMO      128
#define XB_XCNT(j)  (256  + 64 * (j))
#define XB_XSUB(j)  (1280 + 64 * (j))
#define XB_XGEN(j)  (2304 + 64 * (j))
#define XB_TOP      3328
#define XB_TOPGEN   3392
#define XB_SPIN_CAP (1u << 22)
DI unsigned xb_ld(unsigned* p) { return __hip_atomic_load(p, __ATOMIC_RELAXED, __HIP_MEMORY_SCOPE_AGENT); }
DI unsigned xb_add(unsigned* p, unsigned v) { return __hip_atomic_fetch_add(p, v, __ATOMIC_RELAXED, __HIP_MEMORY_SCOPE_AGENT); }
DI unsigned xb_xcc_id() { return (unsigned)__builtin_amdgcn_s_getreg((3 << 11) | 20) & 0xFu; }
#define XB_SPIN(cond, bar) do { unsigned _sp = 0; while (cond) { __builtin_amdgcn_s_sleep(8); \
    if ((++_sp & 255u) == 0u) { if (xb_ld(&(bar)[XB_TMO])) break; if (_sp > XB_SPIN_CAP) { atomicAdd(&(bar)[XB_TMO], 1u); break; } } } } while (0)
struct XcdBarrier { unsigned* bar; unsigned x; volatile LAS unsigned* st; };
DI XcdBarrier xcd_barrier_post(unsigned* bar, volatile LAS unsigned* st) {
    XcdBarrier b; b.bar = bar; b.x = xb_xcc_id(); b.st = st;
    if (threadIdx.x == 0) (void)xb_add(&bar[XB_XCNT(b.x)], 1u);
    return b;
}
DI void xcd_barrier_complete(unsigned* bar, unsigned x, unsigned& nloc, unsigned& nx) {
    const unsigned G = gridDim.x;
    unsigned sum, cnt, mine, sp = 0u;
    for (;;) {
        sum = 0u; cnt = 0u; mine = 0u;
#pragma unroll
        for (unsigned j = 0; j < 16; ++j) { const unsigned c = xb_ld(&bar[XB_XCNT(j)]); sum += c; cnt += (c > 0u) ? 1u : 0u; mine = (j == x) ? c : mine; }
        if (sum == G) break;
        __builtin_amdgcn_s_sleep(1);
        if ((++sp & 255u) == 0u) { if (xb_ld(&bar[XB_TMO])) break; if (sp > XB_SPIN_CAP) { atomicAdd(&bar[XB_TMO], 1u); break; } }
    }
    nloc = mine > 0u ? mine : 1u; nx = cnt > 0u ? cnt : 1u;
}
DI void xcd_barrier(const XcdBarrier& b) {
    asm volatile("s_waitcnt vmcnt(0)" ::: "memory");
    __syncthreads();
    if (threadIdx.x == 0) {
        unsigned* bar = b.bar;
        __builtin_amdgcn_s_waitcnt(0);
        unsigned nloc = b.st[0], nx = b.st[1];
        if (nloc == 0u) { xcd_barrier_complete(bar, b.x, nloc, nx); b.st[0] = nloc; b.st[1] = nx; }
        const unsigned old = xb_add(&bar[XB_XSUB(b.x)], 1u);
        const unsigned gen = old / nloc;
        if (old + 1u == (gen + 1u) * nloc) {
            __builtin_amdgcn_fence(__ATOMIC_RELEASE, "agent");
            asm volatile("s_waitcnt vmcnt(0)" ::: "memory");
            const unsigned og = xb_add(&bar[XB_TOP], 1u);
            const unsigned tg = og / nx;
            if (og + 1u == (tg + 1u) * nx) xb_add(&bar[XB_TOPGEN], 1u);
            else XB_SPIN(xb_ld(&bar[XB_TOPGEN]) == tg, bar);
            __builtin_amdgcn_fence(__ATOMIC_ACQUIRE, "agent");
            xb_add(&bar[XB_XGEN(b.x)], 1u);
            asm volatile("s_waitcnt vmcnt(0)" ::: "memory");
        } else {
            XB_SPIN(xb_ld(&bar[XB_XGEN(b.x)]) == gen, bar);
            __builtin_amdgcn_fence(__ATOMIC_ACQUIRE, "agent");
            asm volatile("s_waitcnt vmcnt(0)" ::: "memory");
        }
    }
    __syncthreads();
}
DI int next_item(unsigned* ctr, volatile LAS int* slot) {
    __syncthreads();
    if (threadIdx.x == 0) *slot = (int)xb_add(ctr, 1u);
    __syncthreads();
    return *slot;
}

constexpr int BM = 256, BK = 64, HALF = 128, HTB = HALF * BK * 2, NXCD = 8, WGM = 8;
DI int lds_byte(int r, int c) { const int st = (r >> 4) * 2 + (c >> 5), rr = r & 15, cc = c & 31, ob = rr * 64 + cc * 2; return st * 1024 + (ob ^ (((ob >> 9) & 1) << 5)); }
DI void stage_rc(int b, int& R, int& C) { const int st = b / 1024, sb = b % 1024, swz = sb ^ (((sb >> 9) & 1) << 5); R = (st >> 1) * 16 + swz / 64; C = (st & 1) * 32 + (swz % 64) / 2; }

struct Unit { int pm, pn, kq; };
struct Sched {
    int nM, nN, nwg, G, c, skip_ctx, split;
    DI void init(int nM_, int nN_, int skip, int split_ = 0) { nM = nM_; nN = nN_; nwg = nM * nN; G = gridDim.x; c = blockIdx.x; skip_ctx = skip; split = split_; }
    DI bool next(int i, Unit& u) const {
        const long L = (long)i * G + c;
        u.kq = -1;
        if (split && L >= nwg) {
            const int q = (int)(L - nwg); if (q >= 128) return false;
            const int cu = q >> 2; u.kq = q & 3; u.pm = (cu >> 3) * 9; u.pn = cu & 7; return true;
        }
        if (L >= nwg) return false;
        int wgid = (int)L; { const int q = nwg / NXCD, r = nwg % NXCD, xcd = wgid % NXCD, off = wgid / NXCD; wgid = (xcd < r ? xcd * (q + 1) : r * (q + 1) + (xcd - r) * q) + off; }
        const int nig = WGM * nN, gid = wgid / nig, fm = gid * WGM, gsz = (nM - fm) < WGM ? (nM - fm) : WGM;
        int pm = fm + ((wgid % nig) % gsz); u.pn = (wgid % nig) / gsz;
        if (skip_ctx) pm = (pm >> 3) * 9 + 1 + (pm & 7);
        u.pm = pm; return true;
    }
};

template <class Epi, bool PERMROWS = false>
DI void gemm_phase(LAS unsigned char* lds, const bf16_t* A, int lda, const bf16_t* Bt, int K, const Sched& S, const Epi& E) {
    int tid = threadIdx.x; asm volatile("" : "+v"(tid));
    const int wid = __builtin_amdgcn_readfirstlane(tid >> 6), lane = tid & 63, wr = wid >> 2, wc = wid & 3, fr = lane & 15, fq = lane >> 4;
    const int ntF = K / BK, ntQ = K / (4 * BK); const size_t qstep = (size_t)(K / 4) * 2;
    unsigned voffA[2], voffB[2];
#pragma unroll
    for (int i = 0; i < 2; ++i) { int R, C; stage_rc(tid * 16 + i * 8192, R, C); const int Ra = PERMROWS ? (((R >> 6) * 16 + (R & 15)) * 8 + ((R >> 4) & 3)) : R;
        voffA[i] = (unsigned)(Ra * lda + C) * 2u; voffB[i] = (unsigned)(R * K + C) * 2u; }
    const size_t kstep = (size_t)(BK * 2);
    const size_t hstepA = (size_t)(PERMROWS ? 4 : HALF) * lda * 2, hstepB = (size_t)HALF * K * 2;
    const size_t tstepA = (size_t)BM * lda * 2, tstepB = 2 * hstepB;
    const unsigned ldsw = (unsigned)wid * 1024u;
    const int aoff = lds_byte(wr * 64 + fr, fq * 8), boff = lds_byte(wc * 32 + fr, fq * 8);
#define G_SA(b, h) (((b) * 2 + (h)) * HTB)
#define G_SB(b, h) ((4 + (b) * 2 + (h)) * HTB)
#define G_STAGE(bufoff, gbase, voff) do { _Pragma("unroll") for (int _i = 0; _i < 2; ++_i) \
        __builtin_amdgcn_global_load_lds((const unsigned*)((const char*)(gbase) + (voff)[_i]), (LAS unsigned*)(lds + (bufoff) + ldsw + _i * 8192), 16, 0, 0); } while (0)
#define G_LDA(dst, b, h) do { _Pragma("unroll") for (int m = 0; m < 4; ++m) _Pragma("unroll") for (int k = 0; k < 2; ++k) dst[m][k] = *(const LAS bf16x8*)(lds + G_SA(b, h) + aoff + m * 2048 + k * 1024); } while (0)
#define G_LDB(dst, b, h) do { _Pragma("unroll") for (int n = 0; n < 2; ++n) _Pragma("unroll") for (int k = 0; k < 2; ++k) dst[n][k] = *(const LAS bf16x8*)(lds + G_SB(b, h) + boff + n * 2048 + k * 1024); } while (0)
#define G_MMA(ai, bj, At, Bt_) do { __builtin_amdgcn_s_setprio(1); _Pragma("unroll") for (int m = 0; m < 4; ++m) _Pragma("unroll") for (int n = 0; n < 2; ++n) _Pragma("unroll") for (int k = 0; k < 2; ++k) \
        acc[ai][bj][m][n] = __builtin_amdgcn_mfma_f32_16x16x32_bf16(Bt_[n][k], At[m][k], acc[ai][bj][m][n], 0, 0, 0); __builtin_amdgcn_s_setprio(0); } while (0)
#define G_WAIT_V(n) asm volatile("s_waitcnt vmcnt(" #n ")" ::: "memory")
#define G_WAIT_L(n) asm volatile("s_waitcnt lgkmcnt(" #n ")" ::: "memory")
#define G_BAR __builtin_amdgcn_s_barrier()
#define G_SCHED __builtin_amdgcn_sched_barrier(0)
    Unit cur, nxt; int ui = 0;
    if (!S.next(0, cur)) return;
    f32x4 acc[2][2][4][2];
#pragma unroll
    for (int a = 0; a < 2; ++a)
#pragma unroll
        for (int b = 0; b < 2; ++b)
#pragma unroll
            for (int m = 0; m < 4; ++m)
#pragma unroll
                for (int n = 0; n < 2; ++n) acc[a][b][m][n] = (f32x4){0.f, 0.f, 0.f, 0.f};
    bf16x8 At[4][2], B0[2][2], B1[2][2];
    const char* cA = (const char*)A + (size_t)cur.pm * tstepA + (cur.kq >= 0 ? cur.kq * qstep : 0); const char* cB = (const char*)Bt + (size_t)cur.pn * tstepB + (cur.kq >= 0 ? cur.kq * qstep : 0);
    int nt = cur.kq >= 0 ? ntQ : ntF;
    G_STAGE(G_SB(0, 0), cB, voffB); G_STAGE(G_SA(0, 0), cA, voffA); G_STAGE(G_SB(0, 1), cB + hstepB, voffB); G_STAGE(G_SA(0, 1), cA + hstepA, voffA);
    if (wr == 1) G_BAR;
    G_WAIT_V(4); G_BAR;
    G_STAGE(G_SB(1, 0), cB + kstep, voffB); G_STAGE(G_SA(1, 0), cA + kstep, voffA); G_STAGE(G_SB(1, 1), cB + hstepB + kstep, voffB);
    G_WAIT_V(6); G_BAR;
    for (;;) {
        const bool has_next = S.next(ui + 1, nxt);
        const char* nA = has_next ? (const char*)A + (size_t)nxt.pm * tstepA + (nxt.kq >= 0 ? nxt.kq * qstep : 0) : cA; const char* nB = has_next ? (const char*)Bt + (size_t)nxt.pn * tstepB + (nxt.kq >= 0 ? nxt.kq * qstep : 0) : cB;
        for (int t = 0; t < nt; t += 2) {
            const bool last = (t == nt - 2);
            const char* a1 = cA + (size_t)(t + 1) * kstep;
            const char* a2 = last ? nA : cA + (size_t)(t + 2) * kstep; const char* b2 = last ? nB : cB + (size_t)(t + 2) * kstep;
            const char* a3 = a2 + kstep; const char* b3 = b2 + kstep;
            G_LDB(B0, 0, 0); G_SCHED; G_LDA(At, 0, 0); G_STAGE(G_SA(1, 1), a1 + hstepA, voffA);
            G_WAIT_L(8); G_BAR; G_WAIT_L(0); G_MMA(0, 0, At, B0); G_BAR; G_SCHED;
            G_LDB(B1, 0, 1); G_STAGE(G_SB(0, 0), b2, voffB);
            G_BAR; G_WAIT_L(0); G_MMA(0, 1, At, B1); G_BAR;
            G_LDA(At, 0, 1); G_STAGE(G_SA(0, 0), a2, voffA);
            G_BAR; G_WAIT_L(0); G_MMA(1, 0, At, B0); G_BAR; G_SCHED;
            G_STAGE(G_SB(0, 1), b2 + hstepB, voffB);
            G_WAIT_V(6); G_BAR; G_MMA(1, 1, At, B1); G_BAR;
            G_LDB(B0, 1, 0); G_SCHED; G_LDA(At, 1, 0); G_STAGE(G_SA(0, 1), a2 + hstepA, voffA);
            G_WAIT_L(8); G_BAR; G_WAIT_L(0); G_MMA(0, 0, At, B0); G_BAR; G_SCHED;
            G_LDB(B1, 1, 1); G_STAGE(G_SB(1, 0), b3, voffB);
            G_BAR; G_WAIT_L(0); G_MMA(0, 1, At, B1); G_BAR;
            G_LDA(At, 1, 1); G_STAGE(G_SA(1, 0), a3, voffA);
            G_BAR; G_WAIT_L(0); G_MMA(1, 0, At, B0); G_BAR; G_SCHED;
            G_STAGE(G_SB(1, 1), b3 + hstepB, voffB);
            G_WAIT_V(6); G_BAR; G_MMA(1, 1, At, B1); G_BAR;
        }
        E(acc, cur, wr, wc, fr, fq);
        if (!has_next) break;
#pragma unroll
        for (int a = 0; a < 2; ++a)
#pragma unroll
            for (int b = 0; b < 2; ++b)
#pragma unroll
                for (int m = 0; m < 4; ++m)
#pragma unroll
                    for (int n = 0; n < 2; ++n) acc[a][b][m][n] = (f32x4){0.f, 0.f, 0.f, 0.f};
        cur = nxt; cA = nA; cB = nB; ++ui; nt = cur.kq >= 0 ? ntQ : ntF;
    }
    G_WAIT_V(0);
    if (wr == 0) G_BAR;
    G_BAR;
#undef G_SA
#undef G_SB
#undef G_STAGE
#undef G_LDA
#undef G_LDB
#undef G_MMA
}

DI void st_bf16x4(bf16_t* p, f32x4 v) { u32x2 w; w.x = cvt_pk_bf16(v[0], v[1]); w.y = cvt_pk_bf16(v[2], v[3]); *(u32x2*)p = w; }
DI void rope4(f32x4& v0, f32x4& v1, const float* tab  ) {
    const f32x4 t0 = *(const f32x4*)tab, t1 = *(const f32x4*)(tab + 4);
    const float c[4] = {t0[0], t0[2], t1[0], t1[2]}, s[4] = {t0[1], t0[3], t1[1], t1[3]};
#pragma unroll
    for (int j = 0; j < 4; ++j) { const float a = v0[j], b = v1[j]; v0[j] = a * c[j] - b * s[j]; v1[j] = b * c[j] + a * s[j]; }
}

struct EpiInproj {
    unsigned char* ws;
    DI void operator()(const f32x4 (&acc)[2][2][4][2], const Unit& u, int wr, int wc, int fr, int fq) const {
        bf16_t* P = (bf16_t*)(ws + WS_P);
        const int b = u.pm / 9;
#pragma unroll
        for (int ai = 0; ai < 2; ++ai)
#pragma unroll
            for (int m = 0; m < 4; ++m) {
                const int row = u.pm * BM + ai * HALF + wr * 64 + m * 16 + fr;
                const int r = row - b * RB; const bool lat = r >= CL; const int t = r - CL;
#pragma unroll
                for (int bj = 0; bj < 2; ++bj) {
                    const int colg = u.pn * BM + bj * HALF + wc * 32;
                    f32x4 v0 = acc[ai][bj][m][0], v1 = acc[ai][bj][m][1];
                    const int c0 = colg + 4 * fq;
                    if (colg >= INW) continue;
                    if (colg >= C_NAV && colg < C_CQ) {
                        bf16_t* vt = (bf16_t*)(ws + WS_VTNA) + ((size_t)b * 768 + (c0 - C_NAV)) * RB + r;
#pragma unroll
                        for (int j = 0; j < 4; ++j) { vt[(size_t)j * RB] = f2bf(v0[j]); vt[(size_t)(16 + j) * RB] = f2bf(v1[j]); }
                    } else if (colg >= C_RV && colg < C_RG) {
                        bf16_t* vt = (bf16_t*)(ws + WS_VTR) + ((size_t)b * 640 + (c0 - C_RV)) * RB + r;
#pragma unroll
                        for (int j = 0; j < 4; ++j) { vt[(size_t)j * RB] = f2bf(v0[j]); vt[(size_t)(16 + j) * RB] = f2bf(v1[j]); }
                    } else if (colg >= C_KPE && colg < C_RQ) {
                        if (lat) rope4(v0, v1, (const float*)(ws + WS_TABM) + ((size_t)t * 32 + ((colg - C_KPE) >> 5) * 16 + 4 * fq) * 2);
                        bf16_t* kp = (bf16_t*)(ws + WS_KPE) + (size_t)row * 64 + (c0 - C_KPE);
                        st_bf16x4(kp, v0); st_bf16x4(kp + 16, v1);
                    } else if (colg >= C_RQ && colg < C_RV) {
                        if (lat) rope4(v0, v1, (const float*)(ws + WS_TABR) + ((size_t)t * 64 + (((colg - C_RQ) & 127) >> 5) * 16 + 4 * fq) * 2);
                        if (colg >= C_RK) {
                            v0 *= 0.08838834764831845f; v1 *= 0.08838834764831845f;
                            bf16_t* kt = (bf16_t*)(ws + WS_KTR) + ((size_t)b * 640 + (c0 - C_RK)) * RB + r;
#pragma unroll
                            for (int j = 0; j < 4; ++j) { kt[(size_t)j * RB] = f2bf(v0[j]); kt[(size_t)(16 + j) * RB] = f2bf(v1[j]); }
                        }
                        st_bf16x4(P + (size_t)row * INP + c0, v0); st_bf16x4(P + (size_t)row * INP + c0 + 16, v1);
                    } else {
                        if (colg >= C_CQ && colg < C_KPE) {
                            float ss = v0[0] * v0[0] + v0[1] * v0[1] + v0[2] * v0[2] + v0[3] * v0[3] + v1[0] * v1[0] + v1[1] * v1[1] + v1[2] * v1[2] + v1[3] * v1[3];
                            ss += __shfl_xor(ss, 16); ss += __shfl_xor(ss, 32);
                            if (fq == 0) ((float*)(ws + WS_SSQ))[(size_t)row * 32 + ((colg - C_CQ) >> 5)] = ss;
                        }
                        st_bf16x4(P + (size_t)row * INP + c0, v0); st_bf16x4(P + (size_t)row * INP + c0 + 16, v1);
                    }
                }
            }
    }
};

DI float row_rstd(const unsigned char* ws, int row, int which, int fq) {
    const f32x4 s4 = *(const f32x4*)((const float*)(ws + WS_SSQ) + (size_t)row * 32 + which * 16 + fq * 4);
    float ss = s4[0] + s4[1] + s4[2] + s4[3];
    ss += __shfl_xor(ss, 16); ss += __shfl_xor(ss, 32);
    return rsqrtf(ss * (1.f / 512.f) + 1e-6f);
}

struct EpiQup {
    unsigned char* ws;
    DI void operator()(const f32x4 (&acc)[2][2][4][2], const Unit& u, int wr, int wc, int fr, int fq) const {
        bf16_t* Q = (bf16_t*)(ws + WS_QM);
        const int b = u.pm / 9;
#pragma unroll
        for (int ai = 0; ai < 2; ++ai)
#pragma unroll
            for (int m = 0; m < 4; ++m) {
                const int row = u.pm * BM + ai * HALF + wr * 64 + m * 16 + fr;
                const int r = row - b * RB; const bool lat = r >= CL; const int t = r - CL;
                const float rs = row_rstd(ws, row, 0, fq);
#pragma unroll
                for (int bj = 0; bj < 2; ++bj) {
                    const int colg = u.pn * BM + bj * HALF + wc * 32;
                    if (colg >= 960) continue;
                    f32x4 v0 = acc[ai][bj][m][0] * rs, v1 = acc[ai][bj][m][1] * rs;
                    const int hc = colg % 192;
                    if (hc >= 128 && lat) rope4(v0, v1, (const float*)(ws + WS_TABM) + ((size_t)t * 32 + ((hc - 128) >> 5) * 16 + 4 * fq) * 2);
                    st_bf16x4(Q + (size_t)row * 960 + colg + 4 * fq, v0); st_bf16x4(Q + (size_t)row * 960 + colg + 4 * fq + 16, v1);
                }
            }
    }
};

struct EpiKVup {
    unsigned char* ws;
    DI void operator()(const f32x4 (&acc)[2][2][4][2], const Unit& u, int wr, int wc, int fr, int fq) const {
        bf16_t* Km = (bf16_t*)(ws + WS_KM);
        const int b = u.pm / 9, head = u.pn;
#pragma unroll
        for (int ai = 0; ai < 2; ++ai)
#pragma unroll
            for (int m = 0; m < 4; ++m) {
                const int row = u.pm * BM + ai * HALF + wr * 64 + m * 16 + fr;
                const int r = row - b * RB;
                const float rs = row_rstd(ws, row, 1, fq);
                {
                    const f32x4 v0 = acc[ai][0][m][0] * rs, v1 = acc[ai][0][m][1] * rs;
                    bf16_t* kp = Km + (size_t)row * 640 + head * 128 + wc * 32 + 4 * fq;
                    st_bf16x4(kp, v0); st_bf16x4(kp + 16, v1);
                }
                {
                    const f32x4 v0 = acc[ai][1][m][0] * rs, v1 = acc[ai][1][m][1] * rs;
                    bf16_t* vt = (bf16_t*)(ws + WS_VTM) + ((size_t)b * 640 + head * 128 + wc * 32 + 4 * fq) * RB + r;
#pragma unroll
                    for (int j = 0; j < 4; ++j) { vt[(size_t)j * RB] = f2bf(v0[j]); vt[(size_t)(16 + j) * RB] = f2bf(v1[j]); }
                }
            }
    }
};

struct EpiResid {
    unsigned char* ws; const float* gate;
    const float* pg; const float* pb;
    DI void operator()(const f32x4 (&acc)[2][2][4][2], const Unit& u, int wr, int wc, int fr, int fq) const {
        float* X = (float*)(ws + WS_X);
        const int b = u.pm / 9; const int s = (u.pm % 9 == 0) ? 4 : b;
        if (u.kq >= 0) {
            float* PT = (float*)(ws + WS_PART) + ((size_t)u.kq * 1024 + b * 256) * DM;
#pragma unroll
            for (int ai = 0; ai < 2; ++ai)
#pragma unroll
                for (int m = 0; m < 4; ++m)
#pragma unroll
                    for (int bj = 0; bj < 2; ++bj)
#pragma unroll
                        for (int n = 0; n < 2; ++n)
                            *(f32x4*)(PT + (size_t)(ai * HALF + wr * 64 + m * 16 + fr) * DM + u.pn * BM + bj * HALF + wc * 32 + n * 16 + 4 * fq) = acc[ai][bj][m][n];
            return;
        }
        const float* g = gate + (size_t)s * 12288;
        const float2* RS = (const float2*)(ws + WS_RSTAT);
#pragma unroll
        for (int ai = 0; ai < 2; ++ai)
#pragma unroll
            for (int m = 0; m < 4; ++m) {
                const int row = u.pm * BM + ai * HALF + wr * 64 + m * 16 + fr;
                float mu = 0.f, rs = 1.f;
                if (pg) { const float2 st = RS[row]; mu = st.x; rs = st.y; }
#pragma unroll
                for (int bj = 0; bj < 2; ++bj)
#pragma unroll
                    for (int n = 0; n < 2; ++n) {
                        const int col = u.pn * BM + bj * HALF + wc * 32 + n * 16 + 4 * fq;
                        float* xp = X + (size_t)row * DM + col;
                        f32x4 x4 = *(const f32x4*)xp; const f32x4 g4 = *(const f32x4*)(g + col);
                        if (pg) x4 = (x4 - mu) * rs * *(const f32x4*)(pg + col) + *(const f32x4*)(pb + col);
                        *(f32x4*)xp = x4 * ALPHA + g4 * acc[ai][bj][m][n];
                    }
            }
    }
};

struct EpiUp {
    unsigned char* ws;
    DI void operator()(const f32x4 (&acc)[2][2][4][2], const Unit& u, int wr, int wc, int fr, int fq) const {
        bf16_t* AU = (bf16_t*)(ws + WS_AU);
#pragma unroll
        for (int ai = 0; ai < 2; ++ai)
#pragma unroll
            for (int m = 0; m < 4; ++m) {
                const int row = u.pm * BM + ai * HALF + wr * 64 + m * 16 + fr;
#pragma unroll
                for (int bj = 0; bj < 2; ++bj)
#pragma unroll
                    for (int n = 0; n < 2; ++n) st_bf16x4(AU + (size_t)row * (2 * DFF) + u.pn * BM + bj * HALF + wc * 32 + n * 16 + 4 * fq, acc[ai][bj][m][n]);
            }
    }
};

struct EpiUpGlu {
    unsigned char* ws; const float* cw; const float* cb;
    DI void operator()(const f32x4 (&acc)[2][2][4][2], const Unit& u, int wr, int wc, int fr, int fq) const {
        bf16_t* G = (bf16_t*)(ws + WS_G);
        float* EA = (float*)(ws + WS_EDGE); float* EP = EA + (size_t)36 * 4 * DFF; float* EU = EP + (size_t)36 * 4 * DFF;
        const int tok0 = (wr * 16 + fr) * 8;
        const size_t row0 = (size_t)u.pm * BM + tok0;
        const bool e_lo = (fr == 0), e_hi = (fr == 15);
#pragma unroll
        for (int n = 0; n < 2; ++n) {
            const int col = u.pn * 128 + wc * 32 + n * 16 + 4 * fq;
            const f32x4 w0 = *(const f32x4*)(cw + col), w1 = *(const f32x4*)(cw + DFF + col), w2 = *(const f32x4*)(cw + 2 * DFF + col), bb = *(const f32x4*)(cb + col);
            f32x4 g[8];
            f32x4 ed_a, ed_p, ed_u;
#pragma unroll
            for (int j = 0; j < 4; ++j) {
                float a[8], uu[8];
#pragma unroll
                for (int k = 0; k < 8; ++k) { a[k] = acc[k >> 2][0][k & 3][n][j]; uu[k] = acc[k >> 2][1][k & 3][n][j]; }
                const float aprev = __shfl_up(a[7], 1), anext = __shfl_down(a[0], 1);
#pragma unroll
                for (int k = 0; k < 8; ++k) {
                    const float c = bb[j] + w0[j] * (k > 0 ? a[k - 1] : aprev) + w1[j] * a[k] + w2[j] * (k < 7 ? a[k + 1] : anext);
                    g[k][j] = silu(c) * uu[k];
                }
                if (e_lo) { ed_a[j] = a[0]; ed_p[j] = bb[j] + w1[j] * a[0] + w2[j] * a[1]; ed_u[j] = uu[0]; }
                if (e_hi) { ed_a[j] = a[7]; ed_p[j] = bb[j] + w0[j] * a[6] + w1[j] * a[7]; ed_u[j] = uu[7]; }
            }
#pragma unroll
            for (int k = 0; k < 8; ++k) {
                if ((k == 0 && e_lo) || (k == 7 && e_hi)) continue;
                st_bf16x4(G + (row0 + k) * DFF + col, g[k]);
            }
            if (e_lo || e_hi) {
                const size_t eo = ((size_t)u.pm * 4 + wr * 2 + (e_hi ? 1 : 0)) * DFF + col;
                *(f32x4*)(EA + eo) = ed_a; *(f32x4*)(EP + eo) = ed_p; *(f32x4*)(EU + eo) = ed_u;
            }
        }
    }
};

DI void conv_witem(const float* W, int K, int Nsrc, bf16_t* dst, const float* rowscale, bool perm_in, int kt, int ntile, int lane, bool glu_rows = false) {
    const int k0 = kt * 16, c0 = ntile * 256, n4 = lane * 4;
    const int cdst = c0 + n4;
    int csrc = cdst;
    if (perm_in && cdst >= C_RQ && cdst < C_RV) { const int pp = cdst & 63, g = pp >> 5, e = pp & 31; csrc = (cdst & ~63) + ((e < 16) ? g * 16 + e : 32 + g * 16 + (e - 16)); }
    const bool valid = csrc < Nsrc;
    const float* src = W + (size_t)k0 * Nsrc + csrc;
    f32x4 v[16];
#pragma unroll
    for (int i = 0; i < 16; ++i) v[i] = valid ? *(const f32x4*)(src + (size_t)i * Nsrc) : (f32x4){0.f, 0.f, 0.f, 0.f};
    if (rowscale) {
#pragma unroll
        for (int i = 0; i < 16; ++i) v[i] *= rowscale[k0 + i];
    }
    int drow = cdst;
    if (glu_rows) { const int hf = cdst >= DFF ? 1 : 0, jj = cdst - hf * DFF; drow = (jj >> 7) * 256 + hf * 128 + (jj & 127); }
    bf16_t* dp = dst + (size_t)drow * K + k0;
#pragma unroll
    for (int j = 0; j < 4; ++j) {
        u32x4 w0, w1;
        w0.x = cvt_pk_bf16(v[0][j], v[1][j]); w0.y = cvt_pk_bf16(v[2][j], v[3][j]); w0.z = cvt_pk_bf16(v[4][j], v[5][j]); w0.w = cvt_pk_bf16(v[6][j], v[7][j]);
        w1.x = cvt_pk_bf16(v[8][j], v[9][j]); w1.y = cvt_pk_bf16(v[10][j], v[11][j]); w1.z = cvt_pk_bf16(v[12][j], v[13][j]); w1.w = cvt_pk_bf16(v[14][j], v[15][j]);
        *(u32x4*)(dp + (size_t)j * K) = w0; *(u32x4*)(dp + (size_t)j * K + 8) = w1;
    }
}

DI void prep_items(const Params& p, LAS unsigned char* lds, int l, unsigned* ctr, int max_items) {
    const int tid = otid(), lane = tid & 63, wid = tid >> 6;
    LAS float* s_c = (LAS float*)lds;
    LAS float* s_red = (LAS float*)(lds + 40960);
    volatile LAS int* slot = (volatile LAS int*)(lds + LDS_CTRL + 64);
    constexpr int N_ADA = 48, PER_L = 12832, N_CONV = PER_L / 8;
    const int n_tab = (l == 0) ? 48 : 0;
    float* mod = (float*)(p.ws + WS_MOD);
    bool have_c = false;
    for (int done = 0; done < max_items; ++done) {
        const int it = next_item(ctr, slot);
        if (it >= N_ADA + n_tab + N_CONV) break;
        if (it < N_ADA) {
            if (!have_c) {
                for (int i = tid; i < 5 * 2048; i += 512) { const int s = i >> 11, k = i & 2047; const float v = s < 4 ? p.in[1][s * 2048 + k] : p.in[3][k]; s_c[i] = silu(v); }
                have_c = true;
                __syncthreads();
            }
            const int n0 = it * 256;
            const float* W = p.in[4] + (size_t)l * 2048 * 12288 + n0 + lane * 4;
            f32x4 a0 = (f32x4){0.f, 0.f, 0.f, 0.f}, a1 = a0, a2 = a0, a3 = a0, a4 = a0;
#pragma unroll 8
            for (int k = wid; k < 2048; k += 8) { const f32x4 w = *(const f32x4*)(W + (size_t)k * 12288); a0 += w * s_c[k]; a1 += w * s_c[2048 + k]; a2 += w * s_c[4096 + k]; a3 += w * s_c[6144 + k]; a4 += w * s_c[8192 + k]; }
            *(LAS f32x4*)(s_red + (wid * 5 + 0) * 256 + lane * 4) = a0; *(LAS f32x4*)(s_red + (wid * 5 + 1) * 256 + lane * 4) = a1; *(LAS f32x4*)(s_red + (wid * 5 + 2) * 256 + lane * 4) = a2;
            *(LAS f32x4*)(s_red + (wid * 5 + 3) * 256 + lane * 4) = a3; *(LAS f32x4*)(s_red + (wid * 5 + 4) * 256 + lane * 4) = a4;
            __syncthreads();
            for (int o = tid; o < 5 * 256; o += 512) { const int s = o >> 8, c = o & 255; float v = p.in[5][l * 12288 + n0 + c];
#pragma unroll
                for (int w = 0; w < 8; ++w) v += s_red[(w * 5 + s) * 256 + c];
                mod[(size_t)(l * 5 + s) * 12288 + n0 + c] = v; }
        } else if (it < N_ADA + n_tab) {
            const int e0 = (it - N_ADA) * 4096 + tid * 8;
#pragma unroll
            for (int i = 0; i < 8; ++i) {
                int e = e0 + i; float2* dst; int t, idx, nf;
                if (e < 65536) { dst = (float2*)(p.ws + WS_TABM) + e; t = e >> 5; idx = e & 31; nf = 16; }
                else { e -= 65536; dst = (float2*)(p.ws + WS_TABR) + e; t = e >> 6; idx = e & 63; nf = 32; }
                const int f = idx % nf; const float pos = (idx < nf) ? (float)(t >> 6) : (float)(t & 63);
                const float inv = exp2f(-(float)f * (13.287712379549449f / (float)nf));
                const float ang = pos * inv;
                float rev = ang * 0.15915494309189535f; rev -= floorf(rev);
                const float rr = rev * 6.283185307179586f;
                *dst = make_float2(__cosf(rr), __sinf(rr));
            }
        } else {
            int id = (it - N_ADA - n_tab) * 8 + wid;
            if (id < 3072) conv_witem(p.in[6] + (size_t)l * 2048 * INW, 2048, INW, (bf16_t*)(p.ws + WS_WIN) + (size_t)l * 6144 * 2048, nullptr, true, id % 128, id / 128, lane);
            else if ((id -= 3072) < 128) conv_witem(p.in[9] + (size_t)l * 512 * 960, 512, 960, (bf16_t*)(p.ws + WS_WUQ) + (size_t)l * 1024 * 512, p.in[7] + l * 512, false, id % 32, id / 32, lane);
            else if ((id -= 128) < 160) conv_witem(p.in[10] + (size_t)l * 512 * 1280, 512, 1280, (bf16_t*)(p.ws + WS_WUKV) + (size_t)l * 1280 * 512, p.in[8] + l * 512, false, id % 32, id / 32, lane);
            else if ((id -= 160) < 1024) conv_witem(p.in[13] + (size_t)l * 2048 * 2048, 2048, 2048, (bf16_t*)(p.ws + WS_WO) + (size_t)l * 2048 * 2048, nullptr, false, id % 128, id / 128, lane);
            else if ((id -= 1024) < 5632) conv_witem(p.in[16] + (size_t)l * 2048 * 11264, 2048, 11264, (bf16_t*)(p.ws + WS_WUP) + (size_t)l * 11264 * 2048, nullptr, false, id % 128, id / 128, lane, true);
            else { id -= 5632; conv_witem(p.in[19] + (size_t)l * 5632 * 2048, 5632, 2048, (bf16_t*)(p.ws + WS_WDN) + (size_t)l * 2048 * 5632, nullptr, false, id % 352, id / 352, lane); }
        }
    }
    __syncthreads();
}
DI void phase_prep(const Params& p, LAS unsigned char* lds) { prep_items(p, lds, 0, (unsigned*)(p.ws + WS_QCTR), 1 << 30); prep_items(p, lds, 1, (unsigned*)(p.ws + WS_QCTR + 256 * 5), 1 << 30); }
DI void deferred_prep(const Params& p, LAS unsigned char* lds, int max_items) { prep_items(p, lds, 1, (unsigned*)(p.ws + WS_QCTR + 256 * 5), max_items); }

DI void phase_init_x(const Params& p) {
    const int tid_ = otid(); const int lane = tid_ & 63, gw = blockIdx.x * 8 + (tid_ >> 6), nw = gridDim.x * 8;
    float* X = (float*)(p.ws + WS_X); bf16_t* H = (bf16_t*)(p.ws + WS_H); const float* mod = (const float*)(p.ws + WS_MOD);
    for (int row = gw; row < MR; row += nw) {
        const int b = row / RB, r = row % RB; const int s = r < CL ? 4 : b;
        const float* src = r < CL ? p.in[2] + ((size_t)b * CL + r) * DM : p.in[0] + ((size_t)b * TL + (r - CL)) * DM;
        const float* sh = mod + (size_t)s * 12288; const float* sc = sh + 2048;
#pragma unroll
        for (int i = 0; i < 8; ++i) {
            const int col = (i * 64 + lane) * 4;
            const f32x4 v = *(const f32x4*)(src + col);
            *(f32x4*)(X + (size_t)row * DM + col) = v;
            const f32x4 s4 = *(const f32x4*)(sh + col), c4 = *(const f32x4*)(sc + col);
            st_bf16x4(H + (size_t)row * DM + col, v * (c4 + 1.f) + s4);
        }
    }
}

DI void phase_ln(const Params& p, const float* gam, const float* bet, const float* modnext  , bool skip_ctx, bool final_out,
                 const float* cgate  , const float* pg, const float* pb  ) {
    const int tid_ = otid(); const int lane = tid_ & 63, gw = blockIdx.x * 8 + (tid_ >> 6), nw = gridDim.x * 8;
    float* X = (float*)(p.ws + WS_X); bf16_t* H = (bf16_t*)(p.ws + WS_H); float2* RS = (float2*)(p.ws + WS_RSTAT);
    for (int rowA = gw; rowA < MR; rowA += 2 * nw) {
        f32x4 v[2][8]; float sum[2] = {0.f, 0.f}; bool act[2]; int rows[2];
#pragma unroll
        for (int q = 0; q < 2; ++q) {
            const int row = rowA + q * nw; rows[q] = row;
            const int b = row / RB, r = row % RB;
            act[q] = row < MR && !(skip_ctx && r < CL);
            if (act[q]) {
                const bool cpart = cgate && r < CL;
                float pmu = 0.f, prs = 1.f;
                if (cpart && pg) { const float2 st = RS[row]; pmu = st.x; prs = st.y; }
#pragma unroll
                for (int i = 0; i < 8; ++i) {
                    const int col = (i * 64 + lane) * 4;
                    v[q][i] = *(const f32x4*)(X + (size_t)row * DM + col);
                    if (cpart) {
                        if (pg) v[q][i] = (v[q][i] - pmu) * prs * *(const f32x4*)(pg + col) + *(const f32x4*)(pb + col);
                        const float* pt = (const float*)(p.ws + WS_PART) + ((size_t)b * 256 + r) * DM + col;
                        const f32x4 ps = *(const f32x4*)pt + *(const f32x4*)(pt + (size_t)1024 * DM) + *(const f32x4*)(pt + (size_t)2048 * DM) + *(const f32x4*)(pt + (size_t)3072 * DM);
                        v[q][i] = v[q][i] * ALPHA + *(const f32x4*)(cgate + col) * ps;
                        *(f32x4*)(X + (size_t)row * DM + col) = v[q][i];
                    }
                }
            } else {
#pragma unroll
                for (int i = 0; i < 8; ++i) v[q][i] = (f32x4){0.f, 0.f, 0.f, 0.f};
            }
        }
#pragma unroll
        for (int q = 0; q < 2; ++q)
#pragma unroll
            for (int i = 0; i < 8; ++i) sum[q] += v[q][i][0] + v[q][i][1] + v[q][i][2] + v[q][i][3];
        float mu[2], sq[2] = {0.f, 0.f}, rs[2];
#pragma unroll
        for (int o = 32; o > 0; o >>= 1) { sum[0] += __shfl_xor(sum[0], o); sum[1] += __shfl_xor(sum[1], o); }
#pragma unroll
        for (int q = 0; q < 2; ++q) {
            mu[q] = sum[q] * (1.f / 2048.f);
#pragma unroll
            for (int i = 0; i < 8; ++i) { v[q][i] -= mu[q]; sq[q] += v[q][i][0] * v[q][i][0] + v[q][i][1] * v[q][i][1] + v[q][i][2] * v[q][i][2] + v[q][i][3] * v[q][i][3]; }
        }
#pragma unroll
        for (int o = 32; o > 0; o >>= 1) { sq[0] += __shfl_xor(sq[0], o); sq[1] += __shfl_xor(sq[1], o); }
#pragma unroll
        for (int q = 0; q < 2; ++q) {
            if (!act[q]) continue;
            rs[q] = rsqrtf(sq[q] * (1.f / 2048.f) + 1e-5f);
            const int row = rows[q]; const int b = row / RB, r = row % RB; const int s = r < CL ? 4 : b;
            if (lane == 0 && !final_out) RS[row] = make_float2(mu[q], rs[q]);
#pragma unroll
            for (int i = 0; i < 8; ++i) {
                const int col = (i * 64 + lane) * 4;
                const f32x4 o = v[q][i] * rs[q] * *(const f32x4*)(gam + col) + *(const f32x4*)(bet + col);
                if (final_out) { *(f32x4*)(p.out + ((size_t)b * TL + (r - CL)) * DM + col) = o; }
                else {
                    const f32x4 s4 = *(const f32x4*)(modnext + (size_t)s * 12288 + col), c4 = *(const f32x4*)(modnext + (size_t)s * 12288 + 2048 + col);
                    st_bf16x4(H + (size_t)row * DM + col, o * (c4 + 1.f) + s4);
                }
            }
        }
    }
}

DI void glu_fix_panel(const Params& p, int l, int pm) {
    unsigned char* ws = p.ws;
    bf16_t* G = (bf16_t*)(ws + WS_G);
    const float* EA = (const float*)(ws + WS_EDGE); const float* EP = EA + (size_t)36 * 4 * DFF; const float* EU = EP + (size_t)36 * 4 * DFF;
    const float* cw = p.in[17] + (size_t)l * 3 * DFF;
    const int tid_ = otid();
    const int pr = pm % 9;
    for (int it = tid_; it < 4 * (DFF / 4); it += 512) {
        const int col = (it % (DFF / 4)) * 4, e = it / (DFF / 4);
        f32x4 nb = (f32x4){0.f, 0.f, 0.f, 0.f}; int tap; int tok;
        if (e == 0) { tap = 0; tok = 0; if (!(pr == 0 || pr == 1)) nb = *(const f32x4*)(EA + ((size_t)(pm - 1) * 4 + 3) * DFF + col); }
        else if (e == 1) { tap = 2; tok = 127; nb = *(const f32x4*)(EA + ((size_t)pm * 4 + 2) * DFF + col); }
        else if (e == 2) { tap = 0; tok = 128; nb = *(const f32x4*)(EA + ((size_t)pm * 4 + 1) * DFF + col); }
        else { tap = 2; tok = 255; if (!(pr == 0 || pr == 8)) nb = *(const f32x4*)(EA + ((size_t)(pm + 1) * 4 + 0) * DFF + col); }
        const f32x4 w = *(const f32x4*)(cw + (size_t)tap * DFF + col);
        const size_t eo = ((size_t)pm * 4 + e) * DFF + col;
        const f32x4 pp = *(const f32x4*)(EP + eo), uu = *(const f32x4*)(EU + eo);
        f32x4 g;
#pragma unroll
        for (int j = 0; j < 4; ++j) g[j] = silu(pp[j] + w[j] * nb[j]) * uu[j];
        st_bf16x4(G + ((size_t)pm * BM + tok) * DFF + col, g);
    }
}

DI void mixer_item_naive(const Params& p, int l, int row, int slot, int lane) {
    const bf16_t* P = (const bf16_t*)(p.ws + WS_P);
    bf16_t* ymix = (bf16_t*)(p.ws + WS_YMIX);
    const int b = row / RB, r = row % RB; const bool lat = r >= CL; const size_t rowb = (size_t)b * RB;
    if (slot < 6) {
        const int h = slot;
        const bf16_t* qp = P + (size_t)row * INP + C_NAQ + h * 128;
        const float q0 = bf2f(qp[lane]), q1 = bf2f(qp[64 + lane]);
        const bf16_t* vt = (const bf16_t*)(p.ws + WS_VTNA) + ((size_t)b * 768 + h * 128) * RB;
        float m = -1e30f, ls = 0.f, o0 = 0.f, o1 = 0.f;
        const int t = r - CL, gr = t >> 6, gc = t & 63;
        const int r0 = min(max(gr - 4, 0), 24), cs = min(max(gc - 8, 0), 48);
        const float* rpb = p.in[11] + (size_t)(l * 6 + h) * 15 * 31;
        const int nk = lat ? 384 : 256;
        for (int kk = 0; kk < nk; ++kk) {
            int tok; float bias = 0.f;
            if (lat && kk < 128) { const int kr = kk >> 4, kc = kk & 15; tok = CL + (r0 + kr) * 64 + cs + kc; bias = rpb[(r0 + kr - gr + 7) * 31 + (cs + kc - gc + 15)]; }
            else tok = lat ? kk - 128 : kk;
            const bf16_t* kp = P + (rowb + tok) * INP + C_NAK + h * 128;
            float s = q0 * bf2f(kp[lane]) + q1 * bf2f(kp[64 + lane]);
            s = wave_sum(s) * 0.08838834764831845f + bias;
            const float mn = fmaxf(m, s), corr = __expf(m - mn), pp = __expf(s - mn);
            ls = ls * corr + pp;
            o0 = o0 * corr + pp * bf2f(vt[(size_t)lane * RB + tok]);
            o1 = o1 * corr + pp * bf2f(vt[(size_t)(64 + lane) * RB + tok]);
            m = mn;
        }
        const float inv = 1.f / ls;
        ymix[(size_t)row * DM + h * 128 + lane] = f2bf(o0 * inv); ymix[(size_t)row * DM + h * 128 + 64 + lane] = f2bf(o1 * inv);
    } else if (slot < 11) {
        const int h = slot - 6;
        const bf16_t* qp = (const bf16_t*)(p.ws + WS_QM) + (size_t)row * 960 + h * 192;
        const float q0 = bf2f(qp[lane]), q1 = bf2f(qp[64 + lane]), q2 = bf2f(qp[128 + lane]);
        const bf16_t* Km = (const bf16_t*)(p.ws + WS_KM); const bf16_t* Kpe = (const bf16_t*)(p.ws + WS_KPE);
        const bf16_t* vt = (const bf16_t*)(p.ws + WS_VTM) + ((size_t)b * 640 + h * 128) * RB;
        float m = -1e30f, ls = 0.f, o0 = 0.f, o1 = 0.f;
        const int nk = lat ? RB : CL;
        for (int n = 0; n < nk; ++n) {
            const bf16_t* kp = Km + (rowb + n) * 640 + h * 128;
            float s = q0 * bf2f(kp[lane]) + q1 * bf2f(kp[64 + lane]) + q2 * bf2f(Kpe[(rowb + n) * 64 + lane]);
            s = wave_sum(s) * 0.07216878364870322f;
            const float mn = fmaxf(m, s), corr = __expf(m - mn), pp = __expf(s - mn);
            ls = ls * corr + pp;
            o0 = o0 * corr + pp * bf2f(vt[(size_t)lane * RB + n]);
            o1 = o1 * corr + pp * bf2f(vt[(size_t)(64 + lane) * RB + n]);
            m = mn;
        }
        const float inv = 1.f / ls;
        ymix[(size_t)row * DM + 768 + h * 128 + lane] = f2bf(o0 * inv); ymix[(size_t)row * DM + 768 + h * 128 + 64 + lane] = f2bf(o1 * inv);
    } else {
        const int h = slot - 11;
        const float lgf = log1pf(-exp2f(p.in[12][(l * 2 + 0) * 5 + h])) * 1.4426950408889634f;
        const float lgb = log1pf(-exp2f(p.in[12][(l * 2 + 1) * 5 + h])) * 1.4426950408889634f;
        const bf16_t* qp = P + (size_t)row * INP + C_RQ + h * 128;
        const float q0 = bf2f(qp[lane]), q1 = bf2f(qp[64 + lane]);
        const bf16_t* vt = (const bf16_t*)(p.ws + WS_VTR) + ((size_t)b * 640 + h * 128) * RB;
        float o0 = 0.f, o1 = 0.f;
        const int nk = lat ? RB : CL; const int t = r - CL;
        for (int n = 0; n < nk; ++n) {
            const bf16_t* kp = P + (rowb + n) * INP + C_RK + h * 128;
            float s = wave_sum(q0 * bf2f(kp[lane]) + q1 * bf2f(kp[64 + lane]));
            float w;
            if (lat) {
                if (n < CL) w = exp2f(lgf * (float)(CL + t - n)) + exp2f(lgb * (float)(TL - t + n));
                else { const int mm = n - CL; w = (mm <= t ? exp2f(lgf * (float)(t - mm)) : 0.f) + (mm >= t ? exp2f(lgb * (float)(mm - t)) : 0.f); }
            } else w = (n <= r ? exp2f(lgf * (float)(r - n)) : 0.f) + (n >= r ? exp2f(lgb * (float)(n - r)) : 0.f);
            s *= w;
            o0 += s * bf2f(vt[(size_t)lane * RB + n]); o1 += s * bf2f(vt[(size_t)(64 + lane) * RB + n]);
        }
        const float mu = wave_sum(o0 + o1) * (1.f / 128.f);
        const float d0 = o0 - mu, d1 = o1 - mu;
        const float rs = rsqrtf(wave_sum(d0 * d0 + d1 * d1) * (1.f / 128.f) + 1e-5f);
        const bf16_t* gp = P + (size_t)row * INP + C_RG + h * 128;
        ymix[(size_t)row * DM + 1408 + h * 128 + lane] = f2bf(d0 * rs * silu(bf2f(gp[lane])));
        ymix[(size_t)row * DM + 1408 + h * 128 + 64 + lane] = f2bf(d1 * rs * silu(bf2f(gp[64 + lane])));
    }
}

#define MFMA16(a, b, c) __builtin_amdgcn_mfma_f32_16x16x32_bf16((a), (b), (c), 0, 0, 0)
DI float fast_exp2(float x) { return __builtin_amdgcn_exp2f(x); }
template <int DK>
DI void dense_attn_item(LAS unsigned char* lds, const bf16_t* Qb, int ldq, const bf16_t* Kb, int ldk, const bf16_t* Kpe, const bf16_t* Vt, int nkeys, float sl2, bf16_t* Ob) {
    const int tid = otid(), lane = tid & 63, wid = tid >> 6, r16 = lane & 15, q4 = lane >> 4;
    constexpr int KS = DK / 32, KCH = DK / 8, KROW = DK * 2 + 16, KTILE = 64 * KROW, VROW = 144, VTILE = 128 * VROW, NKL = (64 * KCH) / 512;
    bf16x8 qf[2][KS];
#pragma unroll
    for (int qg = 0; qg < 2; ++qg)
#pragma unroll
        for (int ks = 0; ks < KS; ++ks) qf[qg][ks] = *(const bf16x8*)(Qb + (size_t)(wid * 32 + qg * 16 + r16) * ldq + ks * 32 + q4 * 8);
    f32x4 oacc[2][8];
#pragma unroll
    for (int qg = 0; qg < 2; ++qg)
#pragma unroll
        for (int d = 0; d < 8; ++d) oacc[qg][d] = (f32x4){0.f, 0.f, 0.f, 0.f};
    float mrun[2] = {-1e30f, -1e30f}, lsum[2] = {0.f, 0.f};
    u32x4 kst[NKL], vst[2];
    const int ntiles = nkeys >> 6;
#define DA_LOAD(key0) do { \
        _Pragma("unroll") for (int i = 0; i < NKL; ++i) { const int cid = tid + i * 512, key = cid / KCH, cc = cid % KCH; \
            const bf16_t* src = (cc < 16) ? Kb + (size_t)((key0) + key) * ldk + cc * 8 : Kpe + (size_t)((key0) + key) * 64 + (cc - 16) * 8; kst[i] = *(const u32x4*)src; } \
        _Pragma("unroll") for (int i = 0; i < 2; ++i) { const int cid = tid + i * 512, dv = cid >> 3, cc = cid & 7; vst[i] = *(const u32x4*)(Vt + (size_t)dv * RB + (key0) + cc * 8); } } while (0)
#define DA_STORE(buf) do { \
        _Pragma("unroll") for (int i = 0; i < NKL; ++i) { const int cid = tid + i * 512, key = cid / KCH, cc = cid % KCH; *(LAS u32x4*)(lds + (buf) * KTILE + key * KROW + cc * 16) = kst[i]; } \
        _Pragma("unroll") for (int i = 0; i < 2; ++i) { const int cid = tid + i * 512, dv = cid >> 3, cc = cid & 7; *(LAS u32x4*)(lds + 2 * KTILE + (buf) * VTILE + dv * VROW + cc * 16) = vst[i]; } } while (0)
    DA_LOAD(0); DA_STORE(0);
    __syncthreads();
    for (int kt = 0; kt < ntiles; ++kt) {
        const int cur = kt & 1;
        if (kt + 1 < ntiles) DA_LOAD((kt + 1) * 64);
        const LAS unsigned char* kb_ = lds + cur * KTILE; const LAS unsigned char* vb_ = lds + 2 * KTILE + cur * VTILE;
#pragma unroll
        for (int kc = 0; kc < 2; ++kc) {
            f32x4 sacc[2][2];
#pragma unroll
            for (int kb = 0; kb < 2; ++kb) {
                sacc[0][kb] = (f32x4){0.f, 0.f, 0.f, 0.f}; sacc[1][kb] = (f32x4){0.f, 0.f, 0.f, 0.f};
#pragma unroll
                for (int kh = 0; kh < KS / 2; ++kh) {
                    const bf16x8 k0 = *(const LAS bf16x8*)(kb_ + ((2 * kc + kb) * 16 + r16) * KROW + (2 * kh) * 64 + q4 * 16);
                    const bf16x8 k1 = *(const LAS bf16x8*)(kb_ + ((2 * kc + kb) * 16 + r16) * KROW + (2 * kh + 1) * 64 + q4 * 16);
                    __builtin_amdgcn_s_setprio(1);
                    sacc[0][kb] = MFMA16(k0, qf[0][2 * kh], sacc[0][kb]); sacc[1][kb] = MFMA16(k0, qf[1][2 * kh], sacc[1][kb]);
                    sacc[0][kb] = MFMA16(k1, qf[0][2 * kh + 1], sacc[0][kb]); sacc[1][kb] = MFMA16(k1, qf[1][2 * kh + 1], sacc[1][kb]);
                    __builtin_amdgcn_s_setprio(0);
                }
            }
            bf16x8 pb[2];
#pragma unroll
            for (int qg = 0; qg < 2; ++qg) {
                float mx = fmaxf(fmaxf(fmaxf(sacc[qg][0][0], sacc[qg][0][1]), fmaxf(sacc[qg][0][2], sacc[qg][0][3])), fmaxf(fmaxf(sacc[qg][1][0], sacc[qg][1][1]), fmaxf(sacc[qg][1][2], sacc[qg][1][3])));
                mx = fmaxf(mx, __shfl_xor(mx, 16)); mx = fmaxf(mx, __shfl_xor(mx, 32));
                const float mnew = fmaxf(mrun[qg], mx * sl2), alpha = fast_exp2(mrun[qg] - mnew);
                mrun[qg] = mnew;
                float ps = 0.f;
#pragma unroll
                for (int kb = 0; kb < 2; ++kb)
#pragma unroll
                    for (int j = 0; j < 4; ++j) { const float pv = fast_exp2(sacc[qg][kb][j] * sl2 - mnew); sacc[qg][kb][j] = pv; ps += pv; }
                lsum[qg] = lsum[qg] * alpha + ps;
#pragma unroll
                for (int d = 0; d < 8; ++d) oacc[qg][d] *= alpha;
                u32x4 w; w.x = cvt_pk_bf16(sacc[qg][0][0], sacc[qg][0][1]); w.y = cvt_pk_bf16(sacc[qg][0][2], sacc[qg][0][3]);
                w.z = cvt_pk_bf16(sacc[qg][1][0], sacc[qg][1][1]); w.w = cvt_pk_bf16(sacc[qg][1][2], sacc[qg][1][3]);
                pb[qg] = __builtin_bit_cast(bf16x8, w);
            }
#pragma unroll
            for (int dh = 0; dh < 4; ++dh) {
                bf16x8 vfr[2];
#pragma unroll
                for (int d4 = 0; d4 < 2; ++d4) {
                    const int d = dh * 2 + d4;
                    const u32x2 lo = *(const LAS u32x2*)(vb_ + (d * 16 + r16) * VROW + (kc * 32 + q4 * 4) * 2);
                    const u32x2 hi = *(const LAS u32x2*)(vb_ + (d * 16 + r16) * VROW + (kc * 32 + 16 + q4 * 4) * 2);
                    u32x4 w; w.x = lo.x; w.y = lo.y; w.z = hi.x; w.w = hi.y;
                    vfr[d4] = __builtin_bit_cast(bf16x8, w);
                }
                __builtin_amdgcn_s_setprio(1);
#pragma unroll
                for (int d4 = 0; d4 < 2; ++d4) { const int d = dh * 2 + d4; oacc[0][d] = MFMA16(vfr[d4], pb[0], oacc[0][d]); oacc[1][d] = MFMA16(vfr[d4], pb[1], oacc[1][d]); }
                __builtin_amdgcn_s_setprio(0);
            }
        }
        if (kt + 1 < ntiles) DA_STORE(cur ^ 1);
        __syncthreads();
    }
#pragma unroll
    for (int qg = 0; qg < 2; ++qg) {
        float l = lsum[qg]; l += __shfl_xor(l, 16); l += __shfl_xor(l, 32);
        const float inv = 1.f / l;
        bf16_t* op = Ob + (size_t)(wid * 32 + qg * 16 + r16) * DM + q4 * 4;
#pragma unroll
        for (int d = 0; d < 8; ++d) st_bf16x4(op + d * 16, oacc[qg][d] * inv);
    }
#undef DA_LOAD
#undef DA_STORE
}

DI void phase_dense_attn(const Params& p, int l, LAS unsigned char* lds) {
    unsigned char* ws = p.ws;
    const bf16_t* P = (const bf16_t*)(ws + WS_P); bf16_t* ymix = (bf16_t*)(ws + WS_YMIX);
    const int n_lat = 4 * 5 * 8, n_ctx = (l == 0) ? (20 + 24) : 0;
    for (int it = blockIdx.x; it < n_lat + n_ctx; it += gridDim.x) {
        if (it < n_lat) {
            const int qb = it & 7, h = (it >> 3) % 5, b = it / 40; const size_t rowb = (size_t)b * RB, row0 = rowb + CL + qb * 256;
            dense_attn_item<192>(lds, (const bf16_t*)(ws + WS_QM) + row0 * 960 + h * 192, 960, (const bf16_t*)(ws + WS_KM) + rowb * 640 + h * 128, 640, (const bf16_t*)(ws + WS_KPE) + rowb * 64,
                                 (const bf16_t*)(ws + WS_VTM) + ((size_t)b * 640 + h * 128) * RB, RB, 0.07216878364870322f * 1.4426950408889634f, ymix + row0 * DM + 768 + h * 128);
        } else if (it < n_lat + 20) {
            const int i2 = it - n_lat, h = i2 % 5, b = i2 / 5; const size_t rowb = (size_t)b * RB;
            dense_attn_item<192>(lds, (const bf16_t*)(ws + WS_QM) + rowb * 960 + h * 192, 960, (const bf16_t*)(ws + WS_KM) + rowb * 640 + h * 128, 640, (const bf16_t*)(ws + WS_KPE) + rowb * 64,
                                 (const bf16_t*)(ws + WS_VTM) + ((size_t)b * 640 + h * 128) * RB, CL, 0.07216878364870322f * 1.4426950408889634f, ymix + rowb * DM + 768 + h * 128);
        } else {
            const int i2 = it - n_lat - 20, h = i2 % 6, b = i2 / 6; const size_t rowb = (size_t)b * RB;
            dense_attn_item<128>(lds, P + rowb * INP + C_NAQ + h * 128, INP, P + rowb * INP + C_NAK + h * 128, INP, nullptr,
                                 (const bf16_t*)(ws + WS_VTNA) + ((size_t)b * 768 + h * 128) * RB, CL, 0.08838834764831845f * 1.4426950408889634f, ymix + rowb * DM + h * 128);
        }
    }
}

DI bf16x8 scale_bf16x8(bf16x8 v, const float* w) {
    u32x4 o;
    o.x = cvt_pk_bf16(bf2f((bf16_t)v[0]) * w[0], bf2f((bf16_t)v[1]) * w[1]); o.y = cvt_pk_bf16(bf2f((bf16_t)v[2]) * w[2], bf2f((bf16_t)v[3]) * w[3]);
    o.z = cvt_pk_bf16(bf2f((bf16_t)v[4]) * w[4], bf2f((bf16_t)v[5]) * w[5]); o.w = cvt_pk_bf16(bf2f((bf16_t)v[6]) * w[6], bf2f((bf16_t)v[7]) * w[7]);
    return __builtin_bit_cast(bf16x8, o);
}
DI bf16x8 scale1_bf16x8(bf16x8 v, float w) {
    u32x4 o;
    o.x = cvt_pk_bf16(bf2f((bf16_t)v[0]) * w, bf2f((bf16_t)v[1]) * w); o.y = cvt_pk_bf16(bf2f((bf16_t)v[2]) * w, bf2f((bf16_t)v[3]) * w);
    o.z = cvt_pk_bf16(bf2f((bf16_t)v[4]) * w, bf2f((bf16_t)v[5]) * w); o.w = cvt_pk_bf16(bf2f((bf16_t)v[6]) * w, bf2f((bf16_t)v[7]) * w);
    return __builtin_bit_cast(bf16x8, o);
}
DI float ret_lg2(const Params& p, int l, int dir, int h) { return log1pf(-exp2f(p.in[12][(l * 2 + dir) * 5 + h])) * 1.4426950408889634f; }

DI void phase_ret_scan(const Params& p, int l, LAS unsigned char* lds) {
    const int tid = otid(), lane = tid & 63, wid = tid >> 6, r16 = lane & 15, q4 = lane >> 4;
    unsigned char* ws = p.ws;
    volatile LAS int* slot = (volatile LAS int*)(lds + LDS_CTRL + 64);
    unsigned* ctr = (unsigned*)(ws + WS_QCTR + 256 * (3 + l));
    constexpr int VRS = RB * 2 + 16;
    for (;;) {
        const int it = next_item(ctr, slot);
        if (it >= 160) break;
        const int dvb = it & 7, h = (it >> 3) % 5, b = it / 40, dkb = wid;
        {
            const bf16_t* vsrc = (const bf16_t*)(ws + WS_VTR) + ((size_t)b * 640 + h * 128 + dvb * 16) * RB;
            u32x4 t[9];
#pragma unroll
            for (int i = 0; i < 9; ++i) { const int cid = tid + i * 512, rr = cid / 288, cc = cid % 288; t[i] = *(const u32x4*)(vsrc + (size_t)rr * RB + cc * 8); }
#pragma unroll
            for (int i = 0; i < 9; ++i) { const int cid = tid + i * 512, rr = cid / 288, cc = cid % 288; *(LAS u32x4*)(lds + rr * VRS + cc * 16) = t[i]; }
        }
        const float lgF = ret_lg2(p, l, 0, h), lgB = ret_lg2(p, l, 1, h), gLf = exp2f(lgF * 128.f), gLb = exp2f(lgB * 128.f);
        float bfw[4], bbw[4], efw[8], ebw[8];
#pragma unroll
        for (int ks = 0; ks < 4; ++ks) { const int p0 = ks * 32 + q4 * 8; bfw[ks] = exp2f(lgF * (float)(127 - p0)); bbw[ks] = exp2f(lgB * (float)p0); }
#pragma unroll
        for (int e = 0; e < 8; ++e) { efw[e] = exp2f(-lgF * (float)e); ebw[e] = exp2f(lgB * (float)e); }
        const bf16_t* kt = (const bf16_t*)(ws + WS_KTR) + ((size_t)b * 640 + h * 128 + dkb * 16 + r16) * RB + q4 * 8;
        const LAS unsigned char* vl = lds + r16 * VRS + q4 * 16;
        bf16_t* sbf = (bf16_t*)(ws + WS_S) + ((size_t)((b * 5 + h) * 2 + 0) * 18) * 16384 + (dvb * 16 + r16) * 128 + dkb * 16 + q4 * 4;
        bf16_t* sbb = sbf + (size_t)18 * 16384;
        f32x4 stf = (f32x4){0.f, 0.f, 0.f, 0.f}, stb = stf;
        bf16x8 caf[4], cab[4];
#pragma unroll
        for (int ks = 0; ks < 4; ++ks) { caf[ks] = *(const bf16x8*)(kt + 0 * 128 + ks * 32); cab[ks] = *(const bf16x8*)(kt + 1 * 128 + ks * 32); }
        __syncthreads();
#pragma unroll 2
        for (int step = 0; step < 18; ++step) {
            const int cf = step, cb = step < 2 ? 1 - step : 19 - step;
            const int sn = step < 17 ? step + 1 : 17;
            const int cfn = sn, cbn = sn < 2 ? 1 - sn : 19 - sn;
            bf16x8 naf[4], nab[4];
#pragma unroll
            for (int ks = 0; ks < 4; ++ks) { naf[ks] = *(const bf16x8*)(kt + cfn * 128 + ks * 32); nab[ks] = *(const bf16x8*)(kt + cbn * 128 + ks * 32); }
            st_bf16x4(sbf + (size_t)cf * 16384, stf); st_bf16x4(sbb + (size_t)cb * 16384, stb);
            f32x4 uf = (f32x4){0.f, 0.f, 0.f, 0.f}, ub = uf;
#pragma unroll
            for (int ks = 0; ks < 4; ++ks) {
                float wf8[8], wb8[8];
#pragma unroll
                for (int e = 0; e < 8; ++e) { wf8[e] = bfw[ks] * efw[e]; wb8[e] = bbw[ks] * ebw[e]; }
                uf = MFMA16(scale_bf16x8(caf[ks], wf8), *(const LAS bf16x8*)(vl + (cf * 128 + ks * 32) * 2), uf);
                ub = MFMA16(scale_bf16x8(cab[ks], wb8), *(const LAS bf16x8*)(vl + (cb * 128 + ks * 32) * 2), ub);
            }
            stf = stf * gLf + uf; stb = stb * gLb + ub;
#pragma unroll
            for (int ks = 0; ks < 4; ++ks) { caf[ks] = naf[ks]; cab[ks] = nab[ks]; }
        }
    }
}

DI void ret_out_item(const Params& p, int l, int b, int h, int c, LAS unsigned char* lds) {
    const int tid = otid(), lane = tid & 63, wid = tid >> 6, r16 = lane & 15, q4 = lane >> 4;
    unsigned char* ws = p.ws;
    const bf16_t* P = (const bf16_t*)(ws + WS_P);
    const float lgf = ret_lg2(p, l, 0, h), lgb = ret_lg2(p, l, 1, h);
    const size_t rowb = (size_t)b * RB; const int tok0 = c * 128, tl = wid * 16 + r16;
    const size_t row = rowb + tok0 + tl;
    constexpr int RS = 272, MB = 128 * RS;
    {
        const bf16_t* Sf = (const bf16_t*)(ws + WS_S) + ((size_t)((b * 5 + h) * 2 + 0) * 18 + c) * 16384;
        const bf16_t* Sb = (const bf16_t*)(ws + WS_S) + ((size_t)((b * 5 + h) * 2 + 1) * 18 + c) * 16384;
        const bf16_t* Kc = P + (rowb + tok0) * INP + C_RK + h * 128;
        const bf16_t* Vc = (const bf16_t*)(ws + WS_VTR) + ((size_t)b * 640 + h * 128) * RB + tok0;
        u32x4 t0[4], t1[4], t2[4], t3[4];
#pragma unroll
        for (int i = 0; i < 4; ++i) {
            const int cid = tid + i * 512, rr = cid >> 4, cc = cid & 15;
            t0[i] = *(const u32x4*)(Sf + rr * 128 + cc * 8); t1[i] = *(const u32x4*)(Sb + rr * 128 + cc * 8);
            t2[i] = *(const u32x4*)(Kc + (size_t)rr * INP + cc * 8); t3[i] = *(const u32x4*)(Vc + (size_t)rr * RB + cc * 8);
        }
#pragma unroll
        for (int i = 0; i < 4; ++i) {
            const int cid = tid + i * 512, rr = cid >> 4, cc = cid & 15;
            *(LAS u32x4*)(lds + 0 * MB + rr * RS + cc * 16) = t0[i]; *(LAS u32x4*)(lds + 1 * MB + rr * RS + cc * 16) = t1[i];
            *(LAS u32x4*)(lds + 2 * MB + rr * RS + cc * 16) = t2[i]; *(LAS u32x4*)(lds + 3 * MB + rr * RS + cc * 16) = t3[i];
        }
    }
    bf16x8 qf[4], qff[4], qfb[4];
    const float qdf = exp2f(lgf * (float)(tl + 1)), qdb = exp2f(lgb * (float)(128 - tl));
#pragma unroll
    for (int ks = 0; ks < 4; ++ks) { qf[ks] = *(const bf16x8*)(P + row * INP + C_RQ + h * 128 + ks * 32 + q4 * 8); qff[ks] = scale1_bf16x8(qf[ks], qdf); qfb[ks] = scale1_bf16x8(qf[ks], qdb); }
    f32x4 oacc[8];
#pragma unroll
    for (int d = 0; d < 8; ++d) oacc[d] = (f32x4){0.f, 0.f, 0.f, 0.f};
    __syncthreads();
    const LAS unsigned char* sfp = lds + 0 * MB + r16 * RS + q4 * 16;
    const LAS unsigned char* sbp = lds + 1 * MB + r16 * RS + q4 * 16;
    const LAS unsigned char* kcp = lds + 2 * MB + r16 * RS + q4 * 16;
    const LAS unsigned char* vtp = lds + 3 * MB + r16 * RS + q4 * 8;
#pragma unroll
    for (int d = 0; d < 8; ++d)
#pragma unroll
        for (int ks = 0; ks < 4; ++ks) {
            oacc[d] = MFMA16(*(const LAS bf16x8*)(sfp + d * 16 * RS + ks * 64), qff[ks], oacc[d]);
            oacc[d] = MFMA16(*(const LAS bf16x8*)(sbp + d * 16 * RS + ks * 64), qfb[ks], oacc[d]);
        }
#pragma unroll
    for (int kc = 0; kc < 4; ++kc) {
        f32x4 s[2];
#pragma unroll
        for (int hf = 0; hf < 2; ++hf) {
            s[hf] = (f32x4){0.f, 0.f, 0.f, 0.f};
#pragma unroll
            for (int ks = 0; ks < 4; ++ks) s[hf] = MFMA16(*(const LAS bf16x8*)(kcp + (2 * kc + hf) * 16 * RS + ks * 64), qf[ks], s[hf]);
#pragma unroll
            for (int j = 0; j < 4; ++j) {
                const int m = (2 * kc + hf) * 16 + q4 * 4 + j, d = tl - m;
                const float w = (d >= 0 ? exp2f(lgf * (float)d) : 0.f) + (d <= 0 ? exp2f(-lgb * (float)d) : 0.f);
                s[hf][j] *= w;
            }
        }
        u32x4 w4; w4.x = cvt_pk_bf16(s[0][0], s[0][1]); w4.y = cvt_pk_bf16(s[0][2], s[0][3]); w4.z = cvt_pk_bf16(s[1][0], s[1][1]); w4.w = cvt_pk_bf16(s[1][2], s[1][3]);
        const bf16x8 pb = __builtin_bit_cast(bf16x8, w4);
#pragma unroll
        for (int d = 0; d < 8; ++d) {
            const u32x2 lo = *(const LAS u32x2*)(vtp + d * 16 * RS + kc * 64), hi = *(const LAS u32x2*)(vtp + d * 16 * RS + kc * 64 + 32);
            u32x4 a4; a4.x = lo.x; a4.y = lo.y; a4.z = hi.x; a4.w = hi.y;
            oacc[d] = MFMA16(__builtin_bit_cast(bf16x8, a4), pb, oacc[d]);
        }
    }
    float sum = 0.f;
#pragma unroll
    for (int d = 0; d < 8; ++d) sum += oacc[d][0] + oacc[d][1] + oacc[d][2] + oacc[d][3];
    sum += __shfl_xor(sum, 16); sum += __shfl_xor(sum, 32);
    const float mu = sum * (1.f / 128.f);
    float sq = 0.f;
#pragma unroll
    for (int d = 0; d < 8; ++d) { oacc[d] -= mu; sq += oacc[d][0] * oacc[d][0] + oacc[d][1] * oacc[d][1] + oacc[d][2] * oacc[d][2] + oacc[d][3] * oacc[d][3]; }
    sq += __shfl_xor(sq, 16); sq += __shfl_xor(sq, 32);
    const float rs = rsqrtf(sq * (1.f / 128.f) + 1e-5f);
    const bf16_t* gp = P + row * INP + C_RG + h * 128 + q4 * 4;
    bf16_t* op = (bf16_t*)(ws + WS_YMIX) + row * DM + 1408 + h * 128 + q4 * 4;
#pragma unroll
    for (int d = 0; d < 8; ++d) {
        const u32x2 g2 = *(const u32x2*)(gp + d * 16);
        f32x4 g; g[0] = __uint_as_float(g2.x << 16); g[1] = __uint_as_float(g2.x & 0xffff0000u); g[2] = __uint_as_float(g2.y << 16); g[3] = __uint_as_float(g2.y & 0xffff0000u);
        f32x4 y;
#pragma unroll
        for (int j = 0; j < 4; ++j) y[j] = oacc[d][j] * rs * silu(g[j]);
        st_bf16x4(op + d * 16, y);
    }
}


DI void na_item(const Params& p, int l, int b, int h, int gr, int jq, int lane) {
    const int r16 = lane & 15, q4 = lane >> 4;
    unsigned char* ws = p.ws;
    const bf16_t* P = (const bf16_t*)(ws + WS_P);
    const int gc = jq * 16 + r16, r0 = min(max(gr - 4, 0), 24), band = min(max(jq * 16 - 8, 0), 32), cs = min(max(gc - 8, 0), 48);
    const size_t rowb = (size_t)b * RB, rowq = rowb + CL + gr * 64 + gc;
    const float sl2 = 0.08838834764831845f * 1.4426950408889634f;
    const float* rpb = p.in[11] + (size_t)(l * 6 + h) * 15 * 31;
    bf16x8 qf[4];
#pragma unroll
    for (int ks = 0; ks < 4; ++ks) qf[ks] = *(const bf16x8*)(P + rowq * INP + C_NAQ + h * 128 + ks * 32 + q4 * 8);
    f32x4 oacc[8];
#pragma unroll
    for (int d = 0; d < 8; ++d) oacc[d] = (f32x4){0.f, 0.f, 0.f, 0.f};
    float mrun = -1e30f, lsum = 0.f;
    const bf16_t* vtb = (const bf16_t*)(ws + WS_VTNA) + ((size_t)b * 768 + h * 128 + r16) * RB + q4 * 4;
    const bf16_t* kbase = P + (rowb + r16) * INP + C_NAK + h * 128 + q4 * 8;
    const int tb0 = CL + r0 * 64 + band;
    bf16x8 kf[2][4];
#pragma unroll
    for (int hf = 0; hf < 2; ++hf)
#pragma unroll
        for (int ks = 0; ks < 4; ++ks) kf[hf][ks] = *(const bf16x8*)(kbase + (size_t)(tb0 + hf * 16) * INP + ks * 32);
#pragma unroll 2
    for (int ch = 0; ch < 16; ++ch) {
        const int tokbase = ch < 8 ? tb0 + ch * 64 : (ch - 8) * 32;
        const int chn = ch < 15 ? ch + 1 : 15;
        const int tokn = chn < 8 ? tb0 + chn * 64 : (chn - 8) * 32;
        u32x2 vlo[8], vhi[8];
#pragma unroll
        for (int d = 0; d < 8; ++d) { vlo[d] = *(const u32x2*)(vtb + (size_t)(d * 16) * RB + tokbase); vhi[d] = *(const u32x2*)(vtb + (size_t)(d * 16) * RB + tokbase + 16); }
        bf16x8 kn[2][4];
#pragma unroll
        for (int hf = 0; hf < 2; ++hf)
#pragma unroll
            for (int ks = 0; ks < 4; ++ks) kn[hf][ks] = *(const bf16x8*)(kbase + (size_t)(tokn + hf * 16) * INP + ks * 32);
        f32x4 s[2];
#pragma unroll
        for (int hf = 0; hf < 2; ++hf) {
            s[hf] = (f32x4){0.f, 0.f, 0.f, 0.f};
#pragma unroll
            for (int ks = 0; ks < 4; ++ks) s[hf] = MFMA16(kf[hf][ks], qf[ks], s[hf]);
        }
        if (ch < 8) {
            const float* rp = rpb + (r0 + ch - gr + 7) * 31;
#pragma unroll
            for (int hf = 0; hf < 2; ++hf)
#pragma unroll
                for (int j = 0; j < 4; ++j) {
                    const int kcol = band + hf * 16 + q4 * 4 + j; const bool inw = kcol >= cs && kcol < cs + 16;
                    const float bias = rp[min(max(kcol - gc + 15, 0), 30)];
                    s[hf][j] = inw ? s[hf][j] * sl2 + bias * 1.4426950408889634f : -1e30f;
                }
        } else { s[0] *= sl2; s[1] *= sl2; }
        float mx = fmaxf(fmaxf(fmaxf(s[0][0], s[0][1]), fmaxf(s[0][2], s[0][3])), fmaxf(fmaxf(s[1][0], s[1][1]), fmaxf(s[1][2], s[1][3])));
        mx = fmaxf(mx, __shfl_xor(mx, 16)); mx = fmaxf(mx, __shfl_xor(mx, 32));
        const float mnew = fmaxf(mrun, mx), alpha = fast_exp2(mrun - mnew);
        mrun = mnew;
        float ps = 0.f;
#pragma unroll
        for (int hf = 0; hf < 2; ++hf)
#pragma unroll
            for (int j = 0; j < 4; ++j) { const float pv = fast_exp2(s[hf][j] - mnew); s[hf][j] = pv; ps += pv; }
        lsum = lsum * alpha + ps;
#pragma unroll
        for (int d = 0; d < 8; ++d) oacc[d] *= alpha;
        u32x4 w4; w4.x = cvt_pk_bf16(s[0][0], s[0][1]); w4.y = cvt_pk_bf16(s[0][2], s[0][3]); w4.z = cvt_pk_bf16(s[1][0], s[1][1]); w4.w = cvt_pk_bf16(s[1][2], s[1][3]);
        const bf16x8 pb = __builtin_bit_cast(bf16x8, w4);
#pragma unroll
        for (int d = 0; d < 8; ++d) {
            u32x4 a4; a4.x = vlo[d].x; a4.y = vlo[d].y; a4.z = vhi[d].x; a4.w = vhi[d].y;
            oacc[d] = MFMA16(__builtin_bit_cast(bf16x8, a4), pb, oacc[d]);
        }
#pragma unroll
        for (int hf = 0; hf < 2; ++hf)
#pragma unroll
            for (int ks = 0; ks < 4; ++ks) kf[hf][ks] = kn[hf][ks];
    }
    float lt = lsum; lt += __shfl_xor(lt, 16); lt += __shfl_xor(lt, 32);
    const float inv = 1.f / lt;
    bf16_t* op = (bf16_t*)(ws + WS_YMIX) + rowq * DM + h * 128 + q4 * 4;
#pragma unroll
    for (int d = 0; d < 8; ++d) st_bf16x4(op + d * 16, oacc[d] * inv);
}

DI void na_block_item(const Params& p, int l, int b, int h, int rp, LAS unsigned char* lds) {
    const int tid = otid(), lane = tid & 63, wid = tid >> 6, r16 = lane & 15, q4 = lane >> 4;
    unsigned char* ws = p.ws;
    const bf16_t* P = (const bf16_t*)(ws + WS_P);
    constexpr int KROW = 272, KTILE = 64 * KROW, VROW = 144, VTILE = 128 * VROW;
    const int gr = 2 * rp + (wid >> 2), jq = wid & 3;
    const int gc = jq * 16 + r16, r0w = min(max(gr - 4, 0), 24), band = min(max(jq * 16 - 8, 0), 32), cs = min(max(gc - 8, 0), 48);
    const int r0a = min(max(2 * rp - 4, 0), 24), r0b = min(max(2 * rp - 3, 0), 24), nloc = r0b + 8 - r0a, ntl = nloc + 4;
    const size_t rowb = (size_t)b * RB, rowq = rowb + CL + gr * 64 + gc;
    const float sl2 = 0.08838834764831845f * 1.4426950408889634f;
    const float* rpb = p.in[11] + (size_t)(l * 6 + h) * 15 * 31;
    bf16x8 qf[4];
#pragma unroll
    for (int ks = 0; ks < 4; ++ks) qf[ks] = *(const bf16x8*)(P + rowq * INP + C_NAQ + h * 128 + ks * 32 + q4 * 8);
    f32x4 oacc[8];
#pragma unroll
    for (int d = 0; d < 8; ++d) oacc[d] = (f32x4){0.f, 0.f, 0.f, 0.f};
    float mrun = -1e30f, lsum = 0.f;
    const bf16_t* kg = P + rowb * INP + C_NAK + h * 128;
    const bf16_t* vg = (const bf16_t*)(ws + WS_VTNA) + ((size_t)b * 768 + h * 128) * RB;
    u32x4 kstA[2], vstA[2], kstB[2], vstB[2];
#define NA_TB(t) ((t) < nloc ? CL + (r0a + (t)) * 64 : ((t) - nloc) * 64)
#define NA_LOAD(t, ks_, vs_) do { const int tb_ = NA_TB(t); \
        _Pragma("unroll") for (int i = 0; i < 2; ++i) { const int cid = tid + i * 512; \
            ks_[i] = *(const u32x4*)(kg + (size_t)(tb_ + (cid >> 4)) * INP + (cid & 15) * 8); \
            vs_[i] = *(const u32x4*)(vg + (size_t)(cid >> 3) * RB + tb_ + (cid & 7) * 8); } } while (0)
#define NA_STORE(buf, ks_, vs_) do { \
        _Pragma("unroll") for (int i = 0; i < 2; ++i) { const int cid = tid + i * 512; \
            *(LAS u32x4*)(lds + (buf) * KTILE + (cid >> 4) * KROW + (cid & 15) * 16) = ks_[i]; \
            *(LAS u32x4*)(lds + 3 * KTILE + (buf) * VTILE + (cid >> 3) * VROW + (cid & 7) * 16) = vs_[i]; } } while (0)
    LAS float* s_rpb = (LAS float*)(lds + 3 * KTILE + 3 * VTILE);
    if (tid < 465) s_rpb[tid] = rpb[tid];
    NA_LOAD(0, kstA, vstA); NA_LOAD(1, kstB, vstB);
    NA_STORE(0, kstA, vstA);
    NA_LOAD(2, kstA, vstA);
    __syncthreads();
    for (int t = 0; t < ntl; ++t) {
        const int cur = t % 3;
        const bool local = t < nloc; const int kr = r0a + t;
        const int nch = local ? ((kr >= r0w && kr < r0w + 8) ? 1 : 0) : 2;
        for (int ci = 0; ci < nch; ++ci) {
            const int toff = local ? band : ci * 32;
            const LAS unsigned char* kb_ = lds + cur * KTILE + (toff + r16) * KROW + q4 * 16;
            const LAS unsigned char* vb_ = lds + 3 * KTILE + cur * VTILE + r16 * VROW + (toff + q4 * 4) * 2;
            float bias8[8];
            if (local) {
                const LAS float* rp_ = s_rpb + (kr - gr + 7) * 31;
#pragma unroll
                for (int e = 0; e < 8; ++e) { const int kcol = band + (e >> 2) * 16 + q4 * 4 + (e & 3); bias8[e] = rp_[min(max(kcol - gc + 15, 0), 30)]; }
            }
            f32x4 s[2];
#pragma unroll
            for (int hf = 0; hf < 2; ++hf) {
                s[hf] = (f32x4){0.f, 0.f, 0.f, 0.f};
#pragma unroll
                for (int ks = 0; ks < 4; ++ks) s[hf] = MFMA16(*(const LAS bf16x8*)(kb_ + hf * 16 * KROW + ks * 64), qf[ks], s[hf]);
            }
            if (local) {
#pragma unroll
                for (int hf = 0; hf < 2; ++hf)
#pragma unroll
                    for (int j = 0; j < 4; ++j) {
                        const int kcol = band + hf * 16 + q4 * 4 + j; const bool inw = kcol >= cs && kcol < cs + 16;
                        s[hf][j] = inw ? s[hf][j] * sl2 + bias8[hf * 4 + j] * 1.4426950408889634f : -1e30f;
                    }
            } else { s[0] *= sl2; s[1] *= sl2; }
            float mx = fmaxf(fmaxf(fmaxf(s[0][0], s[0][1]), fmaxf(s[0][2], s[0][3])), fmaxf(fmaxf(s[1][0], s[1][1]), fmaxf(s[1][2], s[1][3])));
            mx = fmaxf(mx, __shfl_xor(mx, 16)); mx = fmaxf(mx, __shfl_xor(mx, 32));
            const float mnew = fmaxf(mrun, mx), alpha = fast_exp2(mrun - mnew);
            mrun = mnew;
            float ps = 0.f;
#pragma unroll
            for (int hf = 0; hf < 2; ++hf)
#pragma unroll
                for (int j = 0; j < 4; ++j) { const float pv = fast_exp2(s[hf][j] - mnew); s[hf][j] = pv; ps += pv; }
            lsum = lsum * alpha + ps;
#pragma unroll
            for (int d = 0; d < 8; ++d) oacc[d] *= alpha;
            u32x4 w4; w4.x = cvt_pk_bf16(s[0][0], s[0][1]); w4.y = cvt_pk_bf16(s[0][2], s[0][3]); w4.z = cvt_pk_bf16(s[1][0], s[1][1]); w4.w = cvt_pk_bf16(s[1][2], s[1][3]);
            const bf16x8 pb = __builtin_bit_cast(bf16x8, w4);
            __builtin_amdgcn_s_setprio(1);
#pragma unroll
            for (int d = 0; d < 8; ++d) {
                const u32x2 lo = *(const LAS u32x2*)(vb_ + d * 16 * VROW), hi = *(const LAS u32x2*)(vb_ + d * 16 * VROW + 32);
                u32x4 a4; a4.x = lo.x; a4.y = lo.y; a4.z = hi.x; a4.w = hi.y;
                oacc[d] = MFMA16(__builtin_bit_cast(bf16x8, a4), pb, oacc[d]);
            }
            __builtin_amdgcn_s_setprio(0);
        }
        const int nb_ = (t + 1) % 3;
        if (t & 1) { if (t + 1 < ntl) NA_STORE(nb_, kstA, vstA); if (t + 3 < ntl) NA_LOAD(t + 3, kstA, vstA); }
        else       { if (t + 1 < ntl) NA_STORE(nb_, kstB, vstB); if (t + 3 < ntl) NA_LOAD(t + 3, kstB, vstB); }
        __syncthreads();
    }
#undef NA_TB
#undef NA_LOAD
#undef NA_STORE
    float lt = lsum; lt += __shfl_xor(lt, 16); lt += __shfl_xor(lt, 32);
    const float inv = 1.f / lt;
    bf16_t* op = (bf16_t*)(ws + WS_YMIX) + rowq * DM + h * 128 + q4 * 4;
#pragma unroll
    for (int d = 0; d < 8; ++d) st_bf16x4(op + d * 16, oacc[d] * inv);
}

DI void dense192_item(unsigned char* ws, LAS unsigned char* lds, int b, int h, int q0, int nk) {
    const size_t rowb = (size_t)b * RB, row0 = rowb + q0;
    dense_attn_item<192>(lds, (const bf16_t*)(ws + WS_QM) + row0 * 960 + h * 192, 960, (const bf16_t*)(ws + WS_KM) + rowb * 640 + h * 128, 640, (const bf16_t*)(ws + WS_KPE) + rowb * 64,
                         (const bf16_t*)(ws + WS_VTM) + ((size_t)b * 640 + h * 128) * RB, nk, 0.07216878364870322f * 1.4426950408889634f, (bf16_t*)(ws + WS_YMIX) + row0 * DM + 768 + h * 128);
}
DI void phase_mixers(const Params& p, int l, LAS unsigned char* lds) {
    unsigned char* ws = p.ws;
    volatile LAS int* slot = (volatile LAS int*)(lds + LDS_CTRL + 64);
    unsigned* ctr = (unsigned*)(ws + WS_QCTR + 256 * (1 + l));
    const int nc = (l == 0) ? 18 : 16, n_ro = 20 * nc, n_na = 384, n_ctx = (l == 0) ? 44 : 0;
    const int e0 = 160, e1 = e0 + n_ro, e2 = e1 + n_na, e3 = e2 + n_ctx;
    int it = next_item(ctr, slot);
    while (it < e0) { dense192_item(ws, lds, it / 40, (it >> 3) % 5, CL + (it & 7) * 256, RB); it = next_item(ctr, slot); }
    while (it < e1) { const int i2 = it - e0, c = (i2 % nc) + (18 - nc), bh = i2 / nc; ret_out_item(p, l, bh / 5, bh % 5, c, lds); it = next_item(ctr, slot); }
    while (it < e2) { const int i2 = it - e1; na_block_item(p, l, i2 / 96, (i2 >> 4) % 6, i2 & 15, lds); it = next_item(ctr, slot); }
    if (l == 0) {
        while (it < e2 + 20) { const int i2 = it - e2; dense192_item(ws, lds, i2 / 5, i2 % 5, 0, CL); it = next_item(ctr, slot); }
        while (it < e3) {
            const int i2 = it - e2 - 20, h = i2 % 6, b = i2 / 6; const size_t rowb = (size_t)b * RB;
            const bf16_t* P = (const bf16_t*)(ws + WS_P);
            dense_attn_item<128>(lds, P + rowb * INP + C_NAQ + h * 128, INP, P + rowb * INP + C_NAK + h * 128, INP, nullptr,
                                 (const bf16_t*)(ws + WS_VTNA) + ((size_t)b * 768 + h * 128) * RB, CL, 0.08838834764831845f * 1.4426950408889634f, (bf16_t*)(ws + WS_YMIX) + rowb * DM + h * 128);
            it = next_item(ctr, slot);
        }
    }
}

#define IN(k) (true)
#define SEAM(k) do { if ((k) != 19) xcd_barrier(bar); } while (0)
template <int L>
DI void layer_body(const Params& p, LAS unsigned char* lds, cg::grid_group& grid, const XcdBarrier& bar) {
        constexpr int l = L; constexpr int pb = 2 + 9 * l; constexpr bool last = (l == 1);
        unsigned char* ws = p.ws; asm volatile("" : "+s"(ws));
        const float* mod = (const float*)(ws + WS_MOD);
        if (IN(pb + 0)) {
            Sched S; S.init(36, 24, 0); EpiInproj E{ws};
            gemm_phase(lds, (const bf16_t*)(ws + WS_H), DM, (const bf16_t*)(ws + WS_WIN) + (size_t)l * 6144 * 2048, 2048, S, E);
            SEAM(pb + 0);
        }
        if (IN(pb + 1)) {
            { Sched S; S.init(36, 4, 0); EpiQup E{ws}; gemm_phase(lds, (const bf16_t*)(ws + WS_P) + C_CQ, INP, (const bf16_t*)(ws + WS_WUQ) + (size_t)l * 1024 * 512, 512, S, E); }
            { Sched S; S.init(36, 5, 0); EpiKVup E{ws}; gemm_phase(lds, (const bf16_t*)(ws + WS_P) + C_CKV, INP, (const bf16_t*)(ws + WS_WUKV) + (size_t)l * 1280 * 512, 512, S, E); }
            phase_ret_scan(p, l, lds);
            SEAM(pb + 1);
        }
        if (IN(pb + 2)) { phase_mixers(p, l, lds); SEAM(pb + 2); }
        if (IN(pb + 3)) {
            Sched S; S.init(32, 8, 1, last ? 0 : 1); EpiResid E{ws, mod + (size_t)(l * 5) * 12288 + 2 * 2048, l == 0 ? nullptr : p.in[20], l == 0 ? nullptr : p.in[21]};
            gemm_phase(lds, (const bf16_t*)(ws + WS_YMIX), DM, (const bf16_t*)(ws + WS_WO) + (size_t)l * 2048 * 2048, 2048, S, E);
            SEAM(pb + 3);
        }
        if (IN(pb + 4)) { phase_ln(p, p.in[14] + l * DM, p.in[15] + l * DM, mod + (size_t)(l * 5) * 12288 + 3 * 2048, last, false, last ? nullptr : mod + (size_t)(l * 5 + 4) * 12288 + 2 * 2048, nullptr, nullptr); SEAM(pb + 4); }
        if (IN(pb + 5)) {
            Sched S; S.init(last ? 32 : 36, 44, last); EpiUpGlu E{ws, p.in[17] + (size_t)l * 3 * DFF, p.in[18] + (size_t)l * DFF};
            gemm_phase<EpiUpGlu, true>(lds, (const bf16_t*)(ws + WS_H), DM, (const bf16_t*)(ws + WS_WUP) + (size_t)l * 11264 * 2048, 2048, S, E);
            SEAM(pb + 5);
        }
        if (IN(pb + 7)) {
            Sched S; S.init(32, 8, 1, last ? 0 : 1); EpiResid E{ws, mod + (size_t)(l * 5) * 12288 + 5 * 2048, p.in[14] + l * DM, p.in[15] + l * DM};
            { Unit u0; for (int i = 0; i < 2; ++i) if (S.next(i, u0)) glu_fix_panel(p, l, u0.pm);
              asm volatile("s_waitcnt vmcnt(0)" ::: "memory"); __syncthreads(); }
            gemm_phase(lds, (const bf16_t*)(ws + WS_G), DFF, (const bf16_t*)(ws + WS_WDN) + (size_t)l * 2048 * 5632, 5632, S, E);
            SEAM(pb + 7);
        }
        if (IN(pb + 8)) { phase_ln(p, p.in[20] + l * DM, p.in[21] + l * DM, mod + (size_t)((last ? 0 : l + 1) * 5) * 12288, last, last, last ? nullptr : mod + (size_t)(l * 5 + 4) * 12288 + 5 * 2048, p.in[14] + l * DM, p.in[15] + l * DM); SEAM(pb + 8); }
    }

__global__ void __launch_bounds__(512, 2) fwd_kernel(Params p) {
    extern __shared__ __attribute__((aligned(16))) unsigned char smem[];
    LAS unsigned char* lds = (LAS unsigned char*)smem;
    cg::grid_group grid = cg::this_grid();
    if (threadIdx.x < 32) ((volatile LAS unsigned*)(lds + LDS_CTRL))[threadIdx.x] = 0u;
    __syncthreads();
    const XcdBarrier bar = xcd_barrier_post((unsigned*)(p.ws + WS_CTL), (volatile LAS unsigned*)(lds + LDS_CTRL));
    if (p.ph_lo == 0x7fffffff) grid.sync();
    if (IN(0)) { phase_prep(p, lds); xcd_barrier(bar); }
    if (IN(1)) { phase_init_x(p); SEAM(1); }
    layer_body<0>(p, lds, grid, bar);
    layer_body<1>(p, lds, grid, bar);
}

extern "C" void kernel_launch(void* const* d_in, const int* in_sizes, int n_in, void* d_out, int out_size, void* d_ws, size_t ws_size, hipStream_t stream) {
    static int grid = 0;
    if (grid == 0) {
        if (n_in != 22 || ws_size < WS_END) { fprintf(stderr, "kernel_launch: need 22 inputs and %zu bytes of workspace (got %d, %zu)\n", (size_t)WS_END, n_in, ws_size); grid = -1; return; }
        int dev = 0, cus = 0, per_cu = 0;
        hipGetDevice(&dev); hipDeviceGetAttribute(&cus, hipDeviceAttributeMultiprocessorCount, dev);
        if (hipFuncSetAttribute((const void*)fwd_kernel, hipFuncAttributeMaxDynamicSharedMemorySize, LDS_BYTES) != hipSuccess) { fprintf(stderr, "kernel_launch: hipFuncSetAttribute failed\n"); grid = -1; return; }
        hipOccupancyMaxActiveBlocksPerMultiprocessor(&per_cu, (const void*)fwd_kernel, 512, LDS_BYTES);
        if (per_cu < 1) { fprintf(stderr, "kernel_launch: occupancy query says %d blocks per CU\n", per_cu); per_cu = 1; }
        grid = cus * 1;
        (void)hipGetLastError();
    }
    if (grid < 0) return;
    if (hipMemsetAsync((char*)d_ws + WS_CTL, 0, CTL_BYTES, stream) != hipSuccess) { fprintf(stderr, "kernel_launch: memset failed\n"); return; }
    Params p{};
    for (int i = 0; i < 22; ++i) p.in[i] = (const float*)d_in[i];
    p.out = (float*)d_out; p.ws = (unsigned char*)d_ws; p.ph_lo = 0; p.ph_hi = 20;
    void* args[] = {&p};
    hipError_t e = hipLaunchCooperativeKernel((const void*)fwd_kernel, dim3(grid), dim3(512), args, LDS_BYTES, stream);
    if (e != hipSuccess) fprintf(stderr, "cooperative launch failed: %s (grid %d)\n", hipGetErrorString(e), grid);
}
```

```cpp
#include <hip/hip_runtime.h>
#include <hip/hip_cooperative_groups.h>
#include <cstdio>
namespace cg = cooperative_groups;

#define LAS __attribute__((address_space(3)))
#define DI __device__ __forceinline__
typedef unsigned short bf16_t;
typedef short bf16x8 __attribute__((ext_vector_type(8)));
typedef float f32x4 __attribute__((ext_vector_type(4)));
typedef float f32x2 __attribute__((ext_vector_type(2)));
typedef unsigned u32x2 __attribute__((ext_vector_type(2)));
typedef unsigned u32x4 __attribute__((ext_vector_type(4)));

constexpr int DM = 2048, TL = 2048, CL = 256, RB = 2304, MR = 9216;
constexpr int INW = 5952, INP = 6144, DFF = 5632;
constexpr int C_NAQ = 0, C_NAK = 768, C_NAV = 1536, C_CQ = 2304, C_CKV = 2816, C_KPE = 3328, C_RQ = 3392, C_RK = 4032, C_RV = 4672, C_RG = 5312;
constexpr float ALPHA = 1.4142135623730951f;

constexpr size_t al(size_t x) { return (x + 255) & ~(size_t)255; }
constexpr size_t WS_CTL = 0;
constexpr size_t CTL_BYTES = 32768;
constexpr size_t WS_QCTR = 16384;
constexpr size_t WS_MOD = CTL_BYTES;
constexpr size_t WS_TABM = al(WS_MOD + 2ull * 5 * 12288 * 4);
constexpr size_t WS_TABR = al(WS_TABM + 2048ull * 32 * 8);
constexpr size_t WS_SSQ = al(WS_TABR + 2048ull * 64 * 8);
constexpr size_t WS_WIN = al(WS_SSQ + 9216ull * 32 * 4);
constexpr size_t WS_WUQ = al(WS_WIN + 2ull * 6144 * 2048 * 2);
constexpr size_t WS_WUKV = al(WS_WUQ + 2ull * 1024 * 512 * 2);
constexpr size_t WS_WO = al(WS_WUKV + 2ull * 1280 * 512 * 2);
constexpr size_t WS_WUP = al(WS_WO + 2ull * 2048 * 2048 * 2);
constexpr size_t WS_WDN = al(WS_WUP + 2ull * 11264 * 2048 * 2);
constexpr size_t WS_X = al(WS_WDN + 2ull * 2048 * 5632 * 2);
constexpr size_t WS_AU = al(WS_X + 9216ull * 2048 * 4);
constexpr size_t WS_G = al(WS_AU + 9216ull * 11264 * 2);
constexpr size_t WS_H = al(WS_G + 9216ull * 5632 * 2);
constexpr size_t WS_RSTAT = al(WS_H + 9216ull * 2048 * 2);
constexpr size_t WS_END = al(WS_RSTAT + 9216ull * 8);
constexpr size_t WS_EDGE = WS_AU;
constexpr size_t WS_PART = WS_AU + (16ull << 20);
constexpr size_t WS_P = WS_AU;
constexpr size_t WS_VTNA = al(WS_P + 9216ull * 6144 * 2);
constexpr size_t WS_VTR = al(WS_VTNA + 4ull * 768 * 2304 * 2);
constexpr size_t WS_KTR = al(WS_VTR + 4ull * 640 * 2304 * 2);
constexpr size_t WS_QM = al(WS_KTR + 4ull * 640 * 2304 * 2);
constexpr size_t WS_KM = al(WS_QM + 9216ull * 960 * 2);
constexpr size_t WS_VTM = al(WS_KM + 9216ull * 640 * 2);
constexpr size_t WS_KPE = al(WS_VTM + 4ull * 640 * 2304 * 2);
constexpr size_t WS_KTRB = al(WS_KPE + 9216ull * 64 * 2);
static_assert(al(WS_KTRB + 4ull * 640 * 2304 * 2) <= WS_G, "mixer scratch must fit under AU");
constexpr size_t WS_YMIX = WS_G;
constexpr size_t WS_S = al(WS_YMIX + 9216ull * 2048 * 2);
static_assert(al(WS_S + 4ull * 5 * 2 * 18 * 128 * 128 * 2) <= WS_H, "G region too small");

constexpr int LDS_CTRL = 139264;
constexpr int LDS_BYTES = LDS_CTRL + 1024;

struct Params { const float* in[22]; float* out; unsigned char* ws; int ph_lo, ph_hi; };

DI bf16_t f2bf(float x) { unsigned u = __float_as_uint(x); u += 0x7fffu + ((u >> 16) & 1u); return (bf16_t)(u >> 16); }
DI float bf2f(bf16_t h) { return __uint_as_float(((unsigned)h) << 16); }
DI unsigned cvt_pk_bf16(float lo, float hi) { unsigned r; asm volatile("v_cvt_pk_bf16_f32 %0, %1, %2" : "=v"(r) : "v"(lo), "v"(hi)); return r; }
DI float wave_sum(float v) {
#pragma unroll
    for (int o = 32; o > 0; o >>= 1) v += __shfl_xor(v, o);
    return v;
}
DI int otid() { int t = threadIdx.x; asm volatile("" : "+v"(t)); return t; }
DI float silu(float v) { return v * __builtin_amdgcn_rcpf(1.f + __builtin_amdgcn_exp2f(-1.4426950408889634f * v)); }

#define XB_TMO      128
#define XB_XCNT(j)  (256  + 64 * (j))
#define XB_XSUB(j)  (1280 + 64 * (j))
#define XB_XGEN(j)  (2304 + 64 * (j))
#define XB_TOP      3328
#define XB_TOPGEN   3392
#define XB_SPIN_CAP (1u << 22)
DI unsigned xb_ld(unsigned* p) { return __hip_atomic_load(p, __ATOMIC_RELAXED, __HIP_MEMORY_SCOPE_AGENT); }
DI unsigned xb_add(unsigned* p, unsigned v) { return __hip_atomic_fetch_add(p, v, __ATOMIC_RELAXED, __HIP_MEMORY_SCOPE_AGENT); }
DI unsigned xb_xcc_id() { return (unsigned)__builtin_amdgcn_s_getreg((3 << 11) | 20) & 0xFu; }
#define XB_SPIN(cond, bar) do { unsigned _sp = 0; while (cond) { __builtin_amdgcn_s_sleep(8); \
    if ((++_sp & 255u) == 0u) { if (xb_ld(&(bar)[XB_TMO])) break; if (_sp > XB_SPIN_CAP) { atomicAdd(&(bar)[XB_TMO], 1u); break; } } } } while (0)
struct XcdBarrier { unsigned* bar; unsigned x; volatile LAS unsigned* st; };
DI XcdBarrier xcd_barrier_post(unsigned* bar, volatile LAS unsigned* st) {
    XcdBarrier b; b.bar = bar; b.x = xb_xcc_id(); b.st = st;
    if (threadIdx.x == 0) (void)xb_add(&bar[XB_XCNT(b.x)], 1u);
    return b;
}
DI void xcd_barrier_complete(unsigned* bar, unsigned x, unsigned& nloc, unsigned& nx) {
    const unsigned G = gridDim.x;
    unsigned sum, cnt, mine, sp = 0u;
    for (;;) {
        sum = 0u; cnt = 0u; mine = 0u;
#pragma unroll
        for (unsigned j = 0; j < 16; ++j) { const unsigned c = xb_ld(&bar[XB_XCNT(j)]); sum += c; cnt += (c > 0u) ? 1u : 0u; mine = (j == x) ? c : mine; }
        if (sum == G) break;
        __builtin_amdgcn_s_sleep(1);
        if ((++sp & 255u) == 0u) { if (xb_ld(&bar[XB_TMO])) break; if (sp > XB_SPIN_CAP) { atomicAdd(&bar[XB_TMO], 1u); break; } }
    }
    nloc = mine > 0u ? mine : 1u; nx = cnt > 0u ? cnt : 1u;
}
DI void xcd_barrier(const XcdBarrier& b) {
    asm volatile("s_waitcnt vmcnt(0)" ::: "memory");
    __syncthreads();
    if (threadIdx.x == 0) {
        unsigned* bar = b.bar;
        __builtin_amdgcn_s_waitcnt(0);
        unsigned nloc = b.st[0], nx = b.st[1];
        if (nloc == 0u) { xcd_barrier_complete(bar, b.x, nloc, nx); b.st[0] = nloc; b.st[1] = nx; }
        const unsigned old = xb_add(&bar[XB_XSUB(b.x)], 1u);
        const unsigned gen = old / nloc;
        if (old + 1u == (gen + 1u) * nloc) {
            __builtin_amdgcn_fence(__ATOMIC_RELEASE, "agent");
            asm volatile("s_waitcnt vmcnt(0)" ::: "memory");
            const unsigned og = xb_add(&bar[XB_TOP], 1u);
            const unsigned tg = og / nx;
            if (og + 1u == (tg + 1u) * nx) xb_add(&bar[XB_TOPGEN], 1u);
            else XB_SPIN(xb_ld(&bar[XB_TOPGEN]) == tg, bar);
            __builtin_amdgcn_fence(__ATOMIC_ACQUIRE, "agent");
            xb_add(&bar[XB_XGEN(b.x)], 1u);
            asm volatile("s_waitcnt vmcnt(0)" ::: "memory");
        } else {
            XB_SPIN(xb_ld(&bar[XB_XGEN(b.x)]) == gen, bar);
            __builtin_amdgcn_fence(__ATOMIC_ACQUIRE, "agent");
            asm volatile("s_waitcnt vmcnt(0)" ::: "memory");
        }
    }
    __syncthreads();
}
DI int next_item(unsigned* ctr, volatile LAS int* slot) {
    __syncthreads();
    if (threadIdx.x == 0) *slot = (int)xb_add(ctr, 1u);
    __syncthreads();
    return *slot;
}

constexpr int BM = 256, BK = 64, HALF = 128, HTB = HALF * BK * 2, NXCD = 8, WGM = 8;
DI int lds_byte(int r, int c) { const int st = (r >> 4) * 2 + (c >> 5), rr = r & 15, cc = c & 31, ob = rr * 64 + cc * 2; return st * 1024 + (ob ^ (((ob >> 9) & 1) << 5)); }
DI void stage_rc(int b, int& R, int& C) { const int st = b / 1024, sb = b % 1024, swz = sb ^ (((sb >> 9) & 1) << 5); R = (st >> 1) * 16 + swz / 64; C = (st & 1) * 32 + (swz % 64) / 2; }

struct Unit { int pm, pn, kq; };
struct Sched {
    int nM, nN, nwg, G, c, skip_ctx, split;
    DI void init(int nM_, int nN_, int skip, int split_ = 0) { nM = nM_; nN = nN_; nwg = nM * nN; G = gridDim.x; c = blockIdx.x; skip_ctx = skip; split = split_; }
    DI bool next(int i, Unit& u) const {
        const long L = (long)i * G + c;
        u.kq = -1;
        if (split && L >= nwg) {
            const int q = (int)(L - nwg); if (q >= 128) return false;
            const int cu = q >> 2; u.kq = q & 3; u.pm = (cu >> 3) * 9; u.pn = cu & 7; return true;
        }
        if (L >= nwg) return false;
        int wgid = (int)L; { const int q = nwg / NXCD, r = nwg % NXCD, xcd = wgid % NXCD, off = wgid / NXCD; wgid = (xcd < r ? xcd * (q + 1) : r * (q + 1) + (xcd - r) * q) + off; }
        const int nig = WGM * nN, gid = wgid / nig, fm = gid * WGM, gsz = (nM - fm) < WGM ? (nM - fm) : WGM;
        int pm = fm + ((wgid % nig) % gsz); u.pn = (wgid % nig) / gsz;
        if (skip_ctx) pm = (pm >> 3) * 9 + 1 + (pm & 7);
        u.pm = pm; return true;
    }
};

template <class Epi, bool PERMROWS = false>
DI void gemm_phase(LAS unsigned char* lds, const bf16_t* A, int lda, const bf16_t* Bt, int K, const Sched& S, const Epi& E) {
    int tid = threadIdx.x; asm volatile("" : "+v"(tid));
    const int wid = __builtin_amdgcn_readfirstlane(tid >> 6), lane = tid & 63, wr = wid >> 2, wc = wid & 3, fr = lane & 15, fq = lane >> 4;
    const int ntF = K / BK, ntQ = K / (4 * BK); const size_t qstep = (size_t)(K / 4) * 2;
    unsigned voffA[2], voffB[2];
#pragma unroll
    for (int i = 0; i < 2; ++i) { int R, C; stage_rc(tid * 16 + i * 8192, R, C); const int Ra = PERMROWS ? (((R >> 6) * 16 + (R & 15)) * 8 + ((R >> 4) & 3)) : R;
        voffA[i] = (unsigned)(Ra * lda + C) * 2u; voffB[i] = (unsigned)(R * K + C) * 2u; }
    const size_t kstep = (size_t)(BK * 2);
    const size_t hstepA = (size_t)(PERMROWS ? 4 : HALF) * lda * 2, hstepB = (size_t)HALF * K * 2;
    const size_t tstepA = (size_t)BM * lda * 2, tstepB = 2 * hstepB;
    const unsigned ldsw = (unsigned)wid * 1024u;
    const int aoff = lds_byte(wr * 64 + fr, fq * 8), boff = lds_byte(wc * 32 + fr, fq * 8);
#define G_SA(b, h) (((b) * 2 + (h)) * HTB)
#define G_SB(b, h) ((4 + (b) * 2 + (h)) * HTB)
#define G_STAGE(bufoff, gbase, voff) do { _Pragma("unroll") for (int _i = 0; _i < 2; ++_i) \
        __builtin_amdgcn_global_load_lds((const unsigned*)((const char*)(gbase) + (voff)[_i]), (LAS unsigned*)(lds + (bufoff) + ldsw + _i * 8192), 16, 0, 0); } while (0)
#define G_LDA(dst, b, h) do { _Pragma("unroll") for (int m = 0; m < 4; ++m) _Pragma("unroll") for (int k = 0; k < 2; ++k) dst[m][k] = *(const LAS bf16x8*)(lds + G_SA(b, h) + aoff + m * 2048 + k * 1024); } while (0)
#define G_LDB(dst, b, h) do { _Pragma("unroll") for (int n = 0; n < 2; ++n) _Pragma("unroll") for (int k = 0; k < 2; ++k) dst[n][k] = *(const LAS bf16x8*)(lds + G_SB(b, h) + boff + n * 2048 + k * 1024); } while (0)
#define G_MMA(ai, bj, At, Bt_) do { __builtin_amdgcn_s_setprio(1); _Pragma("unroll") for (int m = 0; m < 4; ++m) _Pragma("unroll") for (int n = 0; n < 2; ++n) _Pragma("unroll") for (int k = 0; k < 2; ++k) \
        acc[ai][bj][m][n] = __builtin_amdgcn_mfma_f32_16x16x32_bf16(Bt_[n][k], At[m][k], acc[ai][bj][m][n], 0, 0, 0); __builtin_amdgcn_s_setprio(0); } while (0)
#define G_WAIT_V(n) asm volatile("s_waitcnt vmcnt(" #n ")" ::: "memory")
#define G_WAIT_L(n) asm volatile("s_waitcnt lgkmcnt(" #n ")" ::: "memory")
#define G_BAR __builtin_amdgcn_s_barrier()
#define G_SCHED __builtin_amdgcn_sched_barrier(0)
    Unit cur, nxt; int ui = 0;
    if (!S.next(0, cur)) return;
    f32x4 acc[2][2][4][2];
#pragma unroll
    for (int a = 0; a < 2; ++a)
#pragma unroll
        for (int b = 0; b < 2; ++b)
#pragma unroll
            for (int m = 0; m < 4; ++m)
#pragma unroll
                for (int n = 0; n < 2; ++n) acc[a][b][m][n] = (f32x4){0.f, 0.f, 0.f, 0.f};
    bf16x8 At[4][2], B0[2][2], B1[2][2];
    const char* cA = (const char*)A + (size_t)cur.pm * tstepA + (cur.kq >= 0 ? cur.kq * qstep : 0); const char* cB = (const char*)Bt + (size_t)cur.pn * tstepB + (cur.kq >= 0 ? cur.kq * qstep : 0);
    int nt = cur.kq >= 0 ? ntQ : ntF;
    G_STAGE(G_SB(0, 0), cB, voffB); G_STAGE(G_SA(0, 0), cA, voffA); G_STAGE(G_SB(0, 1), cB + hstepB, voffB); G_STAGE(G_SA(0, 1), cA + hstepA, voffA);
    if (wr == 1) G_BAR;
    G_WAIT_V(4); G_BAR;
    G_STAGE(G_SB(1, 0), cB + kstep, voffB); G_STAGE(G_SA(1, 0), cA + kstep, voffA); G_STAGE(G_SB(1, 1), cB + hstepB + kstep, voffB);
    G_WAIT_V(6); G_BAR;
    for (;;) {
        const bool has_next = S.next(ui + 1, nxt);
        const char* nA = has_next ? (const char*)A + (size_t)nxt.pm * tstepA + (nxt.kq >= 0 ? nxt.kq * qstep : 0) : cA; const char* nB = has_next ? (const char*)Bt + (size_t)nxt.pn * tstepB + (nxt.kq >= 0 ? nxt.kq * qstep : 0) : cB;
        for (int t = 0; t < nt; t += 2) {
            const bool last = (t == nt - 2);
            const char* a1 = cA + (size_t)(t + 1) * kstep;
            const char* a2 = last ? nA : cA + (size_t)(t + 2) * kstep; const char* b2 = last ? nB : cB + (size_t)(t + 2) * kstep;
            const char* a3 = a2 + kstep; const char* b3 = b2 + kstep;
            G_LDB(B0, 0, 0); G_SCHED; G_LDA(At, 0, 0); G_STAGE(G_SA(1, 1), a1 + hstepA, voffA);
            G_WAIT_L(8); G_BAR; G_WAIT_L(0); G_MMA(0, 0, At, B0); G_BAR; G_SCHED;
            G_LDB(B1, 0, 1); G_STAGE(G_SB(0, 0), b2, voffB);
            G_BAR; G_WAIT_L(0); G_MMA(0, 1, At, B1); G_BAR;
            G_LDA(At, 0, 1); G_STAGE(G_SA(0, 0), a2, voffA);
            G_BAR; G_WAIT_L(0); G_MMA(1, 0, At, B0); G_BAR; G_SCHED;
            G_STAGE(G_SB(0, 1), b2 + hstepB, voffB);
            G_WAIT_V(6); G_BAR; G_MMA(1, 1, At, B1); G_BAR;
            G_LDB(B0, 1, 0); G_SCHED; G_LDA(At, 1, 0); G_STAGE(G_SA(0, 1), a2 + hstepA, voffA);
            G_WAIT_L(8); G_BAR; G_WAIT_L(0); G_MMA(0, 0, At, B0); G_BAR; G_SCHED;
            G_LDB(B1, 1, 1); G_STAGE(G_SB(1, 0), b3, voffB);
            G_BAR; G_WAIT_L(0); G_MMA(0, 1, At, B1); G_BAR;
            G_LDA(At, 1, 1); G_STAGE(G_SA(1, 0), a3, voffA);
            G_BAR; G_WAIT_L(0); G_MMA(1, 0, At, B0); G_BAR; G_SCHED;
            G_STAGE(G_SB(1, 1), b3 + hstepB, voffB);
            G_WAIT_V(6); G_BAR; G_MMA(1, 1, At, B1); G_BAR;
        }
        E(acc, cur, wr, wc, fr, fq);
        if (!has_next) break;
#pragma unroll
        for (int a = 0; a < 2; ++a)
#pragma unroll
            for (int b = 0; b < 2; ++b)
#pragma unroll
                for (int m = 0; m < 4; ++m)
#pragma unroll
                    for (int n = 0; n < 2; ++n) acc[a][b][m][n] = (f32x4){0.f, 0.f, 0.f, 0.f};
        cur = nxt; cA = nA; cB = nB; ++ui; nt = cur.kq >= 0 ? ntQ : ntF;
    }
    G_WAIT_V(0);
    if (wr == 0) G_BAR;
    G_BAR;
#undef G_SA
#undef G_SB
#undef G_STAGE
#undef G_LDA
#undef G_LDB
#undef G_MMA
}

DI void st_bf16x4(bf16_t* p, f32x4 v) { u32x2 w; w.x = cvt_pk_bf16(v[0], v[1]); w.y = cvt_pk_bf16(v[2], v[3]); *(u32x2*)p = w; }
DI void rope4(f32x4& v0, f32x4& v1, const float* tab  ) {
    const f32x4 t0 = *(const f32x4*)tab, t1 = *(const f32x4*)(tab + 4);
    const float c[4] = {t0[0], t0[2], t1[0], t1[2]}, s[4] = {t0[1], t0[3], t1[1], t1[3]};
#pragma unroll
    for (int j = 0; j < 4; ++j) { const float a = v0[j], b = v1[j]; v0[j] = a * c[j] - b * s[j]; v1[j] = b * c[j] + a * s[j]; }
}

DI void st_tr16x32(LAS unsigned char* area, bf16_t* dst_f0_t0  , f32x4 v0, f32x4 v1, int fr, int fq, int lane) {
    const unsigned p01 = cvt_pk_bf16(v0[0], v0[1]), p23 = cvt_pk_bf16(v0[2], v0[3]), q01 = cvt_pk_bf16(v1[0], v1[1]), q23 = cvt_pk_bf16(v1[2], v1[3]);
    LAS bf16_t* w = (LAS bf16_t*)(area + (4 * fq) * 32 + fr * 2);
    w[0 * 16] = (bf16_t)(p01 & 0xffffu); w[1 * 16] = (bf16_t)(p01 >> 16); w[2 * 16] = (bf16_t)(p23 & 0xffffu); w[3 * 16] = (bf16_t)(p23 >> 16);
    w[16 * 16] = (bf16_t)(q01 & 0xffffu); w[17 * 16] = (bf16_t)(q01 >> 16); w[18 * 16] = (bf16_t)(q23 & 0xffffu); w[19 * 16] = (bf16_t)(q23 >> 16);
    asm volatile("s_waitcnt lgkmcnt(0)" ::: "memory");
    const u32x4 row = *(const LAS u32x4*)(area + (lane >> 1) * 32 + (lane & 1) * 16);
    asm volatile("" ::: "memory");
    *(u32x4*)(dst_f0_t0 + (size_t)(lane >> 1) * RB + (lane & 1) * 8) = row;
}
struct EpiInproj {
    unsigned char* ws; LAS unsigned char* spare;
    DI void operator()(const f32x4 (&acc)[2][2][4][2], const Unit& u, int wr, int wc, int fr, int fq) const {
        bf16_t* P = (bf16_t*)(ws + WS_P);
        const int b = u.pm / 9;
#pragma unroll
        for (int ai = 0; ai < 2; ++ai)
#pragma unroll
            for (int m = 0; m < 4; ++m) {
                const int row = u.pm * BM + ai * HALF + wr * 64 + m * 16 + fr;
                const int r = row - b * RB; const bool lat = r >= CL; const int t = r - CL;
#pragma unroll
                for (int bj = 0; bj < 2; ++bj) {
                    const int colg = u.pn * BM + bj * HALF + wc * 32;
                    f32x4 v0 = acc[ai][bj][m][0], v1 = acc[ai][bj][m][1];
                    const int c0 = colg + 4 * fq;
                    if (colg >= INW) continue;
                    if (colg >= C_NAV && colg < C_CQ) {
                        st_tr16x32(spare + (wr * 4 + wc) * 1024, (bf16_t*)(ws + WS_VTNA) + ((size_t)b * 768 + (colg - C_NAV)) * RB + (r - fr), v0, v1, fr, fq, fq * 16 + fr);
                    } else if (colg >= C_RV && colg < C_RG) {
                        st_tr16x32(spare + (wr * 4 + wc) * 1024, (bf16_t*)(ws + WS_VTR) + ((size_t)b * 640 + (colg - C_RV)) * RB + (r - fr), v0, v1, fr, fq, fq * 16 + fr);
                    } else if (colg >= C_KPE && colg < C_RQ) {
                        if (lat) rope4(v0, v1, (const float*)(ws + WS_TABM) + ((size_t)t * 32 + ((colg - C_KPE) >> 5) * 16 + 4 * fq) * 2);
                        bf16_t* kp = (bf16_t*)(ws + WS_KPE) + (size_t)row * 64 + (c0 - C_KPE);
                        st_bf16x4(kp, v0); st_bf16x4(kp + 16, v1);
                    } else if (colg >= C_RQ && colg < C_RV) {
                        if (lat) rope4(v0, v1, (const float*)(ws + WS_TABR) + ((size_t)t * 64 + (((colg - C_RQ) & 127) >> 5) * 16 + 4 * fq) * 2);
                        if (colg >= C_RK) {
                            v0 *= 0.08838834764831845f; v1 *= 0.08838834764831845f;
                            st_tr16x32(spare + (wr * 4 + wc) * 1024, (bf16_t*)(ws + WS_KTR) + ((size_t)b * 640 + (colg - C_RK)) * RB + (r - fr), v0, v1, fr, fq, fq * 16 + fr);
                        }
                        st_bf16x4(P + (size_t)row * INP + c0, v0); st_bf16x4(P + (size_t)row * INP + c0 + 16, v1);
                    } else {
                        if (colg >= C_CQ && colg < C_KPE) {
                            float ss = v0[0] * v0[0] + v0[1] * v0[1] + v0[2] * v0[2] + v0[3] * v0[3] + v1[0] * v1[0] + v1[1] * v1[1] + v1[2] * v1[2] + v1[3] * v1[3];
                            ss += __shfl_xor(ss, 16); ss += __shfl_xor(ss, 32);
                            if (fq == 0) ((float*)(ws + WS_SSQ))[(size_t)row * 32 + ((colg - C_CQ) >> 5)] = ss;
                        }
                        st_bf16x4(P + (size_t)row * INP + c0, v0); st_bf16x4(P + (size_t)row * INP + c0 + 16, v1);
                    }
                }
            }
    }
};

DI float row_rstd(const unsigned char* ws, int row, int which, int fq) {
    const f32x4 s4 = *(const f32x4*)((const float*)(ws + WS_SSQ) + (size_t)row * 32 + which * 16 + fq * 4);
    float ss = s4[0] + s4[1] + s4[2] + s4[3];
    ss += __shfl_xor(ss, 16); ss += __shfl_xor(ss, 32);
    return rsqrtf(ss * (1.f / 512.f) + 1e-6f);
}

struct EpiQup {
    unsigned char* ws;
    DI void operator()(const f32x4 (&acc)[2][2][4][2], const Unit& u, int wr, int wc, int fr, int fq) const {
        bf16_t* Q = (bf16_t*)(ws + WS_QM);
        const int b = u.pm / 9;
#pragma unroll
        for (int ai = 0; ai < 2; ++ai)
#pragma unroll
            for (int m = 0; m < 4; ++m) {
                const int row = u.pm * BM + ai * HALF + wr * 64 + m * 16 + fr;
                const int r = row - b * RB; const bool lat = r >= CL; const int t = r - CL;
                const float rs = row_rstd(ws, row, 0, fq);
#pragma unroll
                for (int bj = 0; bj < 2; ++bj) {
                    const int colg = u.pn * BM + bj * HALF + wc * 32;
                    if (colg >= 960) continue;
                    f32x4 v0 = acc[ai][bj][m][0] * rs, v1 = acc[ai][bj][m][1] * rs;
                    const int hc = colg % 192;
                    if (hc >= 128 && lat) rope4(v0, v1, (const float*)(ws + WS_TABM) + ((size_t)t * 32 + ((hc - 128) >> 5) * 16 + 4 * fq) * 2);
                    st_bf16x4(Q + (size_t)row * 960 + colg + 4 * fq, v0); st_bf16x4(Q + (size_t)row * 960 + colg + 4 * fq + 16, v1);
                }
            }
    }
};

struct EpiKVup {
    unsigned char* ws;
    DI void operator()(const f32x4 (&acc)[2][2][4][2], const Unit& u, int wr, int wc, int fr, int fq) const {
        bf16_t* Km = (bf16_t*)(ws + WS_KM);
        const int b = u.pm / 9, head = u.pn;
#pragma unroll
        for (int ai = 0; ai < 2; ++ai)
#pragma unroll
            for (int m = 0; m < 4; ++m) {
                const int row = u.pm * BM + ai * HALF + wr * 64 + m * 16 + fr;
                const int r = row - b * RB;
                const float rs = row_rstd(ws, row, 1, fq);
                {
                    const f32x4 v0 = acc[ai][0][m][0] * rs, v1 = acc[ai][0][m][1] * rs;
                    bf16_t* kp = Km + (size_t)row * 640 + head * 128 + wc * 32 + 4 * fq;
                    st_bf16x4(kp, v0); st_bf16x4(kp + 16, v1);
                }
                {
                    const f32x4 v0 = acc[ai][1][m][0] * rs, v1 = acc[ai][1][m][1] * rs;
                    bf16_t* vt = (bf16_t*)(ws + WS_VTM) + ((size_t)b * 640 + head * 128 + wc * 32 + 4 * fq) * RB + r;
#pragma unroll
                    for (int j = 0; j < 4; ++j) { vt[(size_t)j * RB] = f2bf(v0[j]); vt[(size_t)(16 + j) * RB] = f2bf(v1[j]); }
                }
            }
    }
};

struct EpiResid {
    unsigned char* ws; const float* gate;
    const float* pg; const float* pb;
    DI void operator()(const f32x4 (&acc)[2][2][4][2], const Unit& u, int wr, int wc, int fr, int fq) const {
        float* X = (float*)(ws + WS_X);
        const int b = u.pm / 9; const int s = (u.pm % 9 == 0) ? 4 : b;
        if (u.kq >= 0) {
            float* PT = (float*)(ws + WS_PART) + ((size_t)u.kq * 1024 + b * 256) * DM;
#pragma unroll
            for (int ai = 0; ai < 2; ++ai)
#pragma unroll
                for (int m = 0; m < 4; ++m)
#pragma unroll
                    for (int bj = 0; bj < 2; ++bj)
#pragma unroll
                        for (int n = 0; n < 2; ++n)
                            *(f32x4*)(PT + (size_t)(ai * HALF + wr * 64 + m * 16 + fr) * DM + u.pn * BM + bj * HALF + wc * 32 + n * 16 + 4 * fq) = acc[ai][bj][m][n];
            return;
        }
        const float* g = gate + (size_t)s * 12288;
        const float2* RS = (const float2*)(ws + WS_RSTAT);
#pragma unroll
        for (int ai = 0; ai < 2; ++ai)
#pragma unroll
            for (int m = 0; m < 4; ++m) {
                const int row = u.pm * BM + ai * HALF + wr * 64 + m * 16 + fr;
                float mu = 0.f, rs = 1.f;
                if (pg) { const float2 st = RS[row]; mu = st.x; rs = st.y; }
#pragma unroll
                for (int bj = 0; bj < 2; ++bj)
#pragma unroll
                    for (int n = 0; n < 2; ++n) {
                        const int col = u.pn * BM + bj * HALF + wc * 32 + n * 16 + 4 * fq;
                        float* xp = X + (size_t)row * DM + col;
                        f32x4 x4 = *(const f32x4*)xp; const f32x4 g4 = *(const f32x4*)(g + col);
                        if (pg) x4 = (x4 - mu) * rs * *(const f32x4*)(pg + col) + *(const f32x4*)(pb + col);
                        *(f32x4*)xp = x4 * ALPHA + g4 * acc[ai][bj][m][n];
                    }
            }
    }
};

struct EpiUp {
    unsigned char* ws;
    DI void operator()(const f32x4 (&acc)[2][2][4][2], const Unit& u, int wr, int wc, int fr, int fq) const {
        bf16_t* AU = (bf16_t*)(ws + WS_AU);
#pragma unroll
        for (int ai = 0; ai < 2; ++ai)
#pragma unroll
            for (int m = 0; m < 4; ++m) {
                const int row = u.pm * BM + ai * HALF + wr * 64 + m * 16 + fr;
#pragma unroll
                for (int bj = 0; bj < 2; ++bj)
#pragma unroll
                    for (int n = 0; n < 2; ++n) st_bf16x4(AU + (size_t)row * (2 * DFF) + u.pn * BM + bj * HALF + wc * 32 + n * 16 + 4 * fq, acc[ai][bj][m][n]);
            }
    }
};

struct EpiUpGlu {
    unsigned char* ws; const float* cw; const float* cb;
    DI void operator()(const f32x4 (&acc)[2][2][4][2], const Unit& u, int wr, int wc, int fr, int fq) const {
        bf16_t* G = (bf16_t*)(ws + WS_G);
        float* EA = (float*)(ws + WS_EDGE); float* EP = EA + (size_t)36 * 4 * DFF; float* EU = EP + (size_t)36 * 4 * DFF;
        const int tok0 = (wr * 16 + fr) * 8;
        const size_t row0 = (size_t)u.pm * BM + tok0;
        const bool e_lo = (fr == 0), e_hi = (fr == 15);
#pragma unroll
        for (int n = 0; n < 2; ++n) {
            const int col = u.pn * 128 + wc * 32 + n * 16 + 4 * fq;
            const f32x4 w0 = *(const f32x4*)(cw + col), w1 = *(const f32x4*)(cw + DFF + col), w2 = *(const f32x4*)(cw + 2 * DFF + col), bb = *(const f32x4*)(cb + col);
            f32x4 g[8];
            f32x4 ed_a, ed_p, ed_u;
#pragma unroll
            for (int j = 0; j < 4; ++j) {
                float a[8], uu[8];
#pragma unroll
                for (int k = 0; k < 8; ++k) { a[k] = acc[k >> 2][0][k & 3][n][j]; uu[k] = acc[k >> 2][1][k & 3][n][j]; }
                const float aprev = __shfl_up(a[7], 1), anext = __shfl_down(a[0], 1);
#pragma unroll
                for (int k = 0; k < 8; ++k) {
                    const float c = bb[j] + w0[j] * (k > 0 ? a[k - 1] : aprev) + w1[j] * a[k] + w2[j] * (k < 7 ? a[k + 1] : anext);
                    g[k][j] = silu(c) * uu[k];
                }
                if (e_lo) { ed_a[j] = a[0]; ed_p[j] = bb[j] + w1[j] * a[0] + w2[j] * a[1]; ed_u[j] = uu[0]; }
                if (e_hi) { ed_a[j] = a[7]; ed_p[j] = bb[j] + w0[j] * a[6] + w1[j] * a[7]; ed_u[j] = uu[7]; }
            }
#pragma unroll
            for (int k = 0; k < 8; ++k) {
                if ((k == 0 && e_lo) || (k == 7 && e_hi)) continue;
                st_bf16x4(G + (row0 + k) * DFF + col, g[k]);
            }
            if (e_lo || e_hi) {
                const size_t eo = ((size_t)u.pm * 4 + wr * 2 + (e_hi ? 1 : 0)) * DFF + col;
                *(f32x4*)(EA + eo) = ed_a; *(f32x4*)(EP + eo) = ed_p; *(f32x4*)(EU + eo) = ed_u;
            }
        }
    }
};

DI void conv_witem(const float* W, int K, int Nsrc, bf16_t* dst, const float* rowscale, bool perm_in, int kt, int ntile, int lane, bool glu_rows = false) {
    const int k0 = kt * 16, c0 = ntile * 256, n4 = lane * 4;
    const int cdst = c0 + n4;
    int csrc = cdst;
    if (perm_in && cdst >= C_RQ && cdst < C_RV) { const int pp = cdst & 63, g = pp >> 5, e = pp & 31; csrc = (cdst & ~63) + ((e < 16) ? g * 16 + e : 32 + g * 16 + (e - 16)); }
    const bool valid = csrc < Nsrc;
    const float* src = W + (size_t)k0 * Nsrc + csrc;
    f32x4 v[16];
#pragma unroll
    for (int i = 0; i < 16; ++i) v[i] = valid ? *(const f32x4*)(src + (size_t)i * Nsrc) : (f32x4){0.f, 0.f, 0.f, 0.f};
    if (rowscale) {
#pragma unroll
        for (int i = 0; i < 16; ++i) v[i] *= rowscale[k0 + i];
    }
    int drow = cdst;
    if (glu_rows) { const int hf = cdst >= DFF ? 1 : 0, jj = cdst - hf * DFF; drow = (jj >> 7) * 256 + hf * 128 + (jj & 127); }
    bf16_t* dp = dst + (size_t)drow * K + k0;
#pragma unroll
    for (int j = 0; j < 4; ++j) {
        u32x4 w0, w1;
        w0.x = cvt_pk_bf16(v[0][j], v[1][j]); w0.y = cvt_pk_bf16(v[2][j], v[3][j]); w0.z = cvt_pk_bf16(v[4][j], v[5][j]); w0.w = cvt_pk_bf16(v[6][j], v[7][j]);
        w1.x = cvt_pk_bf16(v[8][j], v[9][j]); w1.y = cvt_pk_bf16(v[10][j], v[11][j]); w1.z = cvt_pk_bf16(v[12][j], v[13][j]); w1.w = cvt_pk_bf16(v[14][j], v[15][j]);
        *(u32x4*)(dp + (size_t)j * K) = w0; *(u32x4*)(dp + (size_t)j * K + 8) = w1;
    }
}

DI void prep_items(const Params& p, LAS unsigned char* lds, int l, unsigned* ctr, int max_items) {
    const int tid = otid(), lane = tid & 63, wid = tid >> 6;
    LAS float* s_c = (LAS float*)lds;
    LAS float* s_red = (LAS float*)(lds + 40960);
    volatile LAS int* slot = (volatile LAS int*)(lds + LDS_CTRL + 64);
    constexpr int N_ADA = 48, PER_L = 12832, N_CONV = PER_L / 8;
    const int n_tab = (l == 0) ? 48 : 0;
    float* mod = (float*)(p.ws + WS_MOD);
    bool have_c = false;
    for (int done = 0; done < max_items; ++done) {
        const int it = next_item(ctr, slot);
        if (it >= N_ADA + n_tab + N_CONV) break;
        if (it < N_ADA) {
            if (!have_c) {
                for (int i = tid; i < 5 * 2048; i += 512) { const int s = i >> 11, k = i & 2047; const float v = s < 4 ? p.in[1][s * 2048 + k] : p.in[3][k]; s_c[i] = silu(v); }
                have_c = true;
                __syncthreads();
            }
            const int n0 = it * 256;
            const float* W = p.in[4] + (size_t)l * 2048 * 12288 + n0 + lane * 4;
            f32x4 a0 = (f32x4){0.f, 0.f, 0.f, 0.f}, a1 = a0, a2 = a0, a3 = a0, a4 = a0;
#pragma unroll 8
            for (int k = wid; k < 2048; k += 8) { const f32x4 w = *(const f32x4*)(W + (size_t)k * 12288); a0 += w * s_c[k]; a1 += w * s_c[2048 + k]; a2 += w * s_c[4096 + k]; a3 += w * s_c[6144 + k]; a4 += w * s_c[8192 + k]; }
            *(LAS f32x4*)(s_red + (wid * 5 + 0) * 256 + lane * 4) = a0; *(LAS f32x4*)(s_red + (wid * 5 + 1) * 256 + lane * 4) = a1; *(LAS f32x4*)(s_red + (wid * 5 + 2) * 256 + lane * 4) = a2;
            *(LAS f32x4*)(s_red + (wid * 5 + 3) * 256 + lane * 4) = a3; *(LAS f32x4*)(s_red + (wid * 5 + 4) * 256 + lane * 4) = a4;
            __syncthreads();
            for (int o = tid; o < 5 * 256; o += 512) { const int s = o >> 8, c = o & 255; float v = p.in[5][l * 12288 + n0 + c];
#pragma unroll
                for (int w = 0; w < 8; ++w) v += s_red[(w * 5 + s) * 256 + c];
                mod[(size_t)(l * 5 + s) * 12288 + n0 + c] = v; }
        } else if (it < N_ADA + n_tab) {
            const int e0 = (it - N_ADA) * 4096 + tid * 8;
#pragma unroll
            for (int i = 0; i < 8; ++i) {
                int e = e0 + i; float2* dst; int t, idx, nf;
                if (e < 65536) { dst = (float2*)(p.ws + WS_TABM) + e; t = e >> 5; idx = e & 31; nf = 16; }
                else { e -= 65536; dst = (float2*)(p.ws + WS_TABR) + e; t = e >> 6; idx = e & 63; nf = 32; }
                const int f = idx % nf; const float pos = (idx < nf) ? (float)(t >> 6) : (float)(t & 63);
                const float inv = exp2f(-(float)f * (13.287712379549449f / (float)nf));
                const float ang = pos * inv;
                float rev = ang * 0.15915494309189535f; rev -= floorf(rev);
                const float rr = rev * 6.283185307179586f;
                *dst = make_float2(__cosf(rr), __sinf(rr));
            }
        } else {
            int id = (it - N_ADA - n_tab) * 8 + wid;
            if (id < 3072) conv_witem(p.in[6] + (size_t)l * 2048 * INW, 2048, INW, (bf16_t*)(p.ws + WS_WIN) + (size_t)l * 6144 * 2048, nullptr, true, id % 128, id / 128, lane);
            else if ((id -= 3072) < 128) conv_witem(p.in[9] + (size_t)l * 512 * 960, 512, 960, (bf16_t*)(p.ws + WS_WUQ) + (size_t)l * 1024 * 512, p.in[7] + l * 512, false, id % 32, id / 32, lane);
            else if ((id -= 128) < 160) conv_witem(p.in[10] + (size_t)l * 512 * 1280, 512, 1280, (bf16_t*)(p.ws + WS_WUKV) + (size_t)l * 1280 * 512, p.in[8] + l * 512, false, id % 32, id / 32, lane);
            else if ((id -= 160) < 1024) conv_witem(p.in[13] + (size_t)l * 2048 * 2048, 2048, 2048, (bf16_t*)(p.ws + WS_WO) + (size_t)l * 2048 * 2048, nullptr, false, id % 128, id / 128, lane);
            else if ((id -= 1024) < 5632) conv_witem(p.in[16] + (size_t)l * 2048 * 11264, 2048, 11264, (bf16_t*)(p.ws + WS_WUP) + (size_t)l * 11264 * 2048, nullptr, false, id % 128, id / 128, lane, true);
            else { id -= 5632; conv_witem(p.in[19] + (size_t)l * 5632 * 2048, 5632, 2048, (bf16_t*)(p.ws + WS_WDN) + (size_t)l * 2048 * 5632, nullptr, false, id % 352, id / 352, lane); }
        }
    }
    __syncthreads();
}
DI void phase_prep(const Params& p, LAS unsigned char* lds) { prep_items(p, lds, 0, (unsigned*)(p.ws + WS_QCTR), 1 << 30); prep_items(p, lds, 1, (unsigned*)(p.ws + WS_QCTR + 256 * 5), 1 << 30); }
DI void deferred_prep(const Params& p, LAS unsigned char* lds, int max_items) { prep_items(p, lds, 1, (unsigned*)(p.ws + WS_QCTR + 256 * 5), max_items); }

DI void phase_init_x(const Params& p) {
    const int tid_ = otid(); const int lane = tid_ & 63, gw = blockIdx.x * 8 + (tid_ >> 6), nw = gridDim.x * 8;
    float* X = (float*)(p.ws + WS_X); bf16_t* H = (bf16_t*)(p.ws + WS_H); const float* mod = (const float*)(p.ws + WS_MOD);
    for (int row = gw; row < MR; row += nw) {
        const int b = row / RB, r = row % RB; const int s = r < CL ? 4 : b;
        const float* src = r < CL ? p.in[2] + ((size_t)b * CL + r) * DM : p.in[0] + ((size_t)b * TL + (r - CL)) * DM;
        const float* sh = mod + (size_t)s * 12288; const float* sc = sh + 2048;
#pragma unroll
        for (int i = 0; i < 8; ++i) {
            const int col = (i * 64 + lane) * 4;
            const f32x4 v = *(const f32x4*)(src + col);
            *(f32x4*)(X + (size_t)row * DM + col) = v;
            const f32x4 s4 = *(const f32x4*)(sh + col), c4 = *(const f32x4*)(sc + col);
            st_bf16x4(H + (size_t)row * DM + col, v * (c4 + 1.f) + s4);
        }
    }
}

DI void phase_ln(const Params& p, const float* gam, const float* bet, const float* modnext  , bool skip_ctx, bool final_out,
                 const float* cgate  , const float* pg, const float* pb  ) {
    const int tid_ = otid(); const int lane = tid_ & 63, gw = blockIdx.x * 8 + (tid_ >> 6), nw = gridDim.x * 8;
    float* X = (float*)(p.ws + WS_X); bf16_t* H = (bf16_t*)(p.ws + WS_H); float2* RS = (float2*)(p.ws + WS_RSTAT);
    for (int rowA = gw; rowA < MR; rowA += 2 * nw) {
        f32x4 v[2][8]; float sum[2] = {0.f, 0.f}; bool act[2]; int rows[2];
#pragma unroll
        for (int q = 0; q < 2; ++q) {
            const int row = rowA + q * nw; rows[q] = row;
            const int b = row / RB, r = row % RB;
            act[q] = row < MR && !(skip_ctx && r < CL);
            if (act[q]) {
                const bool cpart = cgate && r < CL;
                float pmu = 0.f, prs = 1.f;
                if (cpart && pg) { const float2 st = RS[row]; pmu = st.x; prs = st.y; }
#pragma unroll
                for (int i = 0; i < 8; ++i) {
                    const int col = (i * 64 + lane) * 4;
                    v[q][i] = *(const f32x4*)(X + (size_t)row * DM + col);
                    if (cpart) {
                        if (pg) v[q][i] = (v[q][i] - pmu) * prs * *(const f32x4*)(pg + col) + *(const f32x4*)(pb + col);
                        const float* pt = (const float*)(p.ws + WS_PART) + ((size_t)b * 256 + r) * DM + col;
                        const f32x4 ps = *(const f32x4*)pt + *(const f32x4*)(pt + (size_t)1024 * DM) + *(const f32x4*)(pt + (size_t)2048 * DM) + *(const f32x4*)(pt + (size_t)3072 * DM);
                        v[q][i] = v[q][i] * ALPHA + *(const f32x4*)(cgate + col) * ps;
                        *(f32x4*)(X + (size_t)row * DM + col) = v[q][i];
                    }
                }
            } else {
#pragma unroll
                for (int i = 0; i < 8; ++i) v[q][i] = (f32x4){0.f, 0.f, 0.f, 0.f};
            }
        }
#pragma unroll
        for (int q = 0; q < 2; ++q)
#pragma unroll
            for (int i = 0; i < 8; ++i) sum[q] += v[q][i][0] + v[q][i][1] + v[q][i][2] + v[q][i][3];
        float mu[2], sq[2] = {0.f, 0.f}, rs[2];
#pragma unroll
        for (int o = 32; o > 0; o >>= 1) { sum[0] += __shfl_xor(sum[0], o); sum[1] += __shfl_xor(sum[1], o); }
#pragma unroll
        for (int q = 0; q < 2; ++q) {
            mu[q] = sum[q] * (1.f / 2048.f);
#pragma unroll
            for (int i = 0; i < 8; ++i) { v[q][i] -= mu[q]; sq[q] += v[q][i][0] * v[q][i][0] + v[q][i][1] * v[q][i][1] + v[q][i][2] * v[q][i][2] + v[q][i][3] * v[q][i][3]; }
        }
#pragma unroll
        for (int o = 32; o > 0; o >>= 1) { sq[0] += __shfl_xor(sq[0], o); sq[1] += __shfl_xor(sq[1], o); }
#pragma unroll
        for (int q = 0; q < 2; ++q) {
            if (!act[q]) continue;
            rs[q] = rsqrtf(sq[q] * (1.f / 2048.f) + 1e-5f);
            const int row = rows[q]; const int b = row / RB, r = row % RB; const int s = r < CL ? 4 : b;
            if (lane == 0 && !final_out) RS[row] = make_float2(mu[q], rs[q]);
#pragma unroll
            for (int i = 0; i < 8; ++i) {
                const int col = (i * 64 + lane) * 4;
                const f32x4 o = v[q][i] * rs[q] * *(const f32x4*)(gam + col) + *(const f32x4*)(bet + col);
                if (final_out) { *(f32x4*)(p.out + ((size_t)b * TL + (r - CL)) * DM + col) = o; }
                else {
                    const f32x4 s4 = *(const f32x4*)(modnext + (size_t)s * 12288 + col), c4 = *(const f32x4*)(modnext + (size_t)s * 12288 + 2048 + col);
                    st_bf16x4(H + (size_t)row * DM + col, o * (c4 + 1.f) + s4);
                }
            }
        }
    }
}

DI void glu_fix_panel(const Params& p, int l, int pm) {
    unsigned char* ws = p.ws;
    bf16_t* G = (bf16_t*)(ws + WS_G);
    const float* EA = (const float*)(ws + WS_EDGE); const float* EP = EA + (size_t)36 * 4 * DFF; const float* EU = EP + (size_t)36 * 4 * DFF;
    const float* cw = p.in[17] + (size_t)l * 3 * DFF;
    const int tid_ = otid();
    const int pr = pm % 9;
    for (int it = tid_; it < 4 * (DFF / 4); it += 512) {
        const int col = (it % (DFF / 4)) * 4, e = it / (DFF / 4);
        f32x4 nb = (f32x4){0.f, 0.f, 0.f, 0.f}; int tap; int tok;
        if (e == 0) { tap = 0; tok = 0; if (!(pr == 0 || pr == 1)) nb = *(const f32x4*)(EA + ((size_t)(pm - 1) * 4 + 3) * DFF + col); }
        else if (e == 1) { tap = 2; tok = 127; nb = *(const f32x4*)(EA + ((size_t)pm * 4 + 2) * DFF + col); }
        else if (e == 2) { tap = 0; tok = 128; nb = *(const f32x4*)(EA + ((size_t)pm * 4 + 1) * DFF + col); }
        else { tap = 2; tok = 255; if (!(pr == 0 || pr == 8)) nb = *(const f32x4*)(EA + ((size_t)(pm + 1) * 4 + 0) * DFF + col); }
        const f32x4 w = *(const f32x4*)(cw + (size_t)tap * DFF + col);
        const size_t eo = ((size_t)pm * 4 + e) * DFF + col;
        const f32x4 pp = *(const f32x4*)(EP + eo), uu = *(const f32x4*)(EU + eo);
        f32x4 g;
#pragma unroll
        for (int j = 0; j < 4; ++j) g[j] = silu(pp[j] + w[j] * nb[j]) * uu[j];
        st_bf16x4(G + ((size_t)pm * BM + tok) * DFF + col, g);
    }
}

DI void mixer_item_naive(const Params& p, int l, int row, int slot, int lane) {
    const bf16_t* P = (const bf16_t*)(p.ws + WS_P);
    bf16_t* ymix = (bf16_t*)(p.ws + WS_YMIX);
    const int b = row / RB, r = row % RB; const bool lat = r >= CL; const size_t rowb = (size_t)b * RB;
    if (slot < 6) {
        const int h = slot;
        const bf16_t* qp = P + (size_t)row * INP + C_NAQ + h * 128;
        const float q0 = bf2f(qp[lane]), q1 = bf2f(qp[64 + lane]);
        const bf16_t* vt = (const bf16_t*)(p.ws + WS_VTNA) + ((size_t)b * 768 + h * 128) * RB;
        float m = -1e30f, ls = 0.f, o0 = 0.f, o1 = 0.f;
        const int t = r - CL, gr = t >> 6, gc = t & 63;
        const int r0 = min(max(gr - 4, 0), 24), cs = min(max(gc - 8, 0), 48);
        const float* rpb = p.in[11] + (size_t)(l * 6 + h) * 15 * 31;
        const int nk = lat ? 384 : 256;
        for (int kk = 0; kk < nk; ++kk) {
            int tok; float bias = 0.f;
            if (lat && kk < 128) { const int kr = kk >> 4, kc = kk & 15; tok = CL + (r0 + kr) * 64 + cs + kc; bias = rpb[(r0 + kr - gr + 7) * 31 + (cs + kc - gc + 15)]; }
            else tok = lat ? kk - 128 : kk;
            const bf16_t* kp = P + (rowb + tok) * INP + C_NAK + h * 128;
            float s = q0 * bf2f(kp[lane]) + q1 * bf2f(kp[64 + lane]);
            s = wave_sum(s) * 0.08838834764831845f + bias;
            const float mn = fmaxf(m, s), corr = __expf(m - mn), pp = __expf(s - mn);
            ls = ls * corr + pp;
            o0 = o0 * corr + pp * bf2f(vt[(size_t)lane * RB + tok]);
            o1 = o1 * corr + pp * bf2f(vt[(size_t)(64 + lane) * RB + tok]);
            m = mn;
        }
        const float inv = 1.f / ls;
        ymix[(size_t)row * DM + h * 128 + lane] = f2bf(o0 * inv); ymix[(size_t)row * DM + h * 128 + 64 + lane] = f2bf(o1 * inv);
    } else if (slot < 11) {
        const int h = slot - 6;
        const bf16_t* qp = (const bf16_t*)(p.ws + WS_QM) + (size_t)row * 960 + h * 192;
        const float q0 = bf2f(qp[lane]), q1 = bf2f(qp[64 + lane]), q2 = bf2f(qp[128 + lane]);
        const bf16_t* Km = (const bf16_t*)(p.ws + WS_KM); const bf16_t* Kpe = (const bf16_t*)(p.ws + WS_KPE);
        const bf16_t* vt = (const bf16_t*)(p.ws + WS_VTM) + ((size_t)b * 640 + h * 128) * RB;
        float m = -1e30f, ls = 0.f, o0 = 0.f, o1 = 0.f;
        const int nk = lat ? RB : CL;
        for (int n = 0; n < nk; ++n) {
            const bf16_t* kp = Km + (rowb + n) * 640 + h * 128;
            float s = q0 * bf2f(kp[lane]) + q1 * bf2f(kp[64 + lane]) + q2 * bf2f(Kpe[(rowb + n) * 64 + lane]);
            s = wave_sum(s) * 0.07216878364870322f;
            const float mn = fmaxf(m, s), corr = __expf(m - mn), pp = __expf(s - mn);
            ls = ls * corr + pp;
            o0 = o0 * corr + pp * bf2f(vt[(size_t)lane * RB + n]);
            o1 = o1 * corr + pp * bf2f(vt[(size_t)(64 + lane) * RB + n]);
            m = mn;
        }
        const float inv = 1.f / ls;
        ymix[(size_t)row * DM + 768 + h * 128 + lane] = f2bf(o0 * inv); ymix[(size_t)row * DM + 768 + h * 128 + 64 + lane] = f2bf(o1 * inv);
    } else {
        const int h = slot - 11;
        const float lgf = log1pf(-exp2f(p.in[12][(l * 2 + 0) * 5 + h])) * 1.4426950408889634f;
        const float lgb = log1pf(-exp2f(p.in[12][(l * 2 + 1) * 5 + h])) * 1.4426950408889634f;
        const bf16_t* qp = P + (size_t)row * INP + C_RQ + h * 128;
        const float q0 = bf2f(qp[lane]), q1 = bf2f(qp[64 + lane]);
        const bf16_t* vt = (const bf16_t*)(p.ws + WS_VTR) + ((size_t)b * 640 + h * 128) * RB;
        float o0 = 0.f, o1 = 0.f;
        const int nk = lat ? RB : CL; const int t = r - CL;
        for (int n = 0; n < nk; ++n) {
            const bf16_t* kp = P + (rowb + n) * INP + C_RK + h * 128;
            float s = wave_sum(q0 * bf2f(kp[lane]) + q1 * bf2f(kp[64 + lane]));
            float w;
            if (lat) {
                if (n < CL) w = exp2f(lgf * (float)(CL + t - n)) + exp2f(lgb * (float)(TL - t + n));
                else { const int mm = n - CL; w = (mm <= t ? exp2f(lgf * (float)(t - mm)) : 0.f) + (mm >= t ? exp2f(lgb * (float)(mm - t)) : 0.f); }
            } else w = (n <= r ? exp2f(lgf * (float)(r - n)) : 0.f) + (n >= r ? exp2f(lgb * (float)(n - r)) : 0.f);
            s *= w;
            o0 += s * bf2f(vt[(size_t)lane * RB + n]); o1 += s * bf2f(vt[(size_t)(64 + lane) * RB + n]);
        }
        const float mu = wave_sum(o0 + o1) * (1.f / 128.f);
        const float d0 = o0 - mu, d1 = o1 - mu;
        const float rs = rsqrtf(wave_sum(d0 * d0 + d1 * d1) * (1.f / 128.f) + 1e-5f);
        const bf16_t* gp = P + (size_t)row * INP + C_RG + h * 128;
        ymix[(size_t)row * DM + 1408 + h * 128 + lane] = f2bf(d0 * rs * silu(bf2f(gp[lane])));
        ymix[(size_t)row * DM + 1408 + h * 128 + 64 + lane] = f2bf(d1 * rs * silu(bf2f(gp[64 + lane])));
    }
}

#define MFMA16(a, b, c) __builtin_amdgcn_mfma_f32_16x16x32_bf16((a), (b), (c), 0, 0, 0)
DI float fast_exp2(float x) { return __builtin_amdgcn_exp2f(x); }
template <int DK>
DI void dense_attn_item(LAS unsigned char* lds, const bf16_t* Qb, int ldq, const bf16_t* Kb, int ldk, const bf16_t* Kpe, const bf16_t* Vt, int nkeys, float sl2, bf16_t* Ob) {
    const int tid = otid(), lane = tid & 63, wid = tid >> 6, r16 = lane & 15, q4 = lane >> 4;
    constexpr int KS = DK / 32, KCH = DK / 8, KROW = DK * 2 + 16, KTILE = 64 * KROW, VROW = 144, VTILE = 128 * VROW, NKL = (64 * KCH) / 512;
    bf16x8 qf[2][KS];
#pragma unroll
    for (int qg = 0; qg < 2; ++qg)
#pragma unroll
        for (int ks = 0; ks < KS; ++ks) qf[qg][ks] = *(const bf16x8*)(Qb + (size_t)(wid * 32 + qg * 16 + r16) * ldq + ks * 32 + q4 * 8);
    f32x4 oacc[2][8];
#pragma unroll
    for (int qg = 0; qg < 2; ++qg)
#pragma unroll
        for (int d = 0; d < 8; ++d) oacc[qg][d] = (f32x4){0.f, 0.f, 0.f, 0.f};
    float mrun[2] = {-1e30f, -1e30f}, lsum[2] = {0.f, 0.f};
    u32x4 kst[NKL], vst[2];
    const int ntiles = nkeys >> 6;
#define DA_LOAD(key0) do { \
        _Pragma("unroll") for (int i = 0; i < NKL; ++i) { const int cid = tid + i * 512, key = cid / KCH, cc = cid % KCH; \
            const bf16_t* src = (cc < 16) ? Kb + (size_t)((key0) + key) * ldk + cc * 8 : Kpe + (size_t)((key0) + key) * 64 + (cc - 16) * 8; kst[i] = *(const u32x4*)src; } \
        _Pragma("unroll") for (int i = 0; i < 2; ++i) { const int cid = tid + i * 512, dv = cid >> 3, cc = cid & 7; vst[i] = *(const u32x4*)(Vt + (size_t)dv * RB + (key0) + cc * 8); } } while (0)
#define DA_STORE(buf) do { \
        _Pragma("unroll") for (int i = 0; i < NKL; ++i) { const int cid = tid + i * 512, key = cid / KCH, cc = cid % KCH; *(LAS u32x4*)(lds + (buf) * KTILE + key * KROW + cc * 16) = kst[i]; } \
        _Pragma("unroll") for (int i = 0; i < 2; ++i) { const int cid = tid + i * 512, dv = cid >> 3, cc = cid & 7; *(LAS u32x4*)(lds + 2 * KTILE + (buf) * VTILE + dv * VROW + cc * 16) = vst[i]; } } while (0)
    DA_LOAD(0); DA_STORE(0);
    __syncthreads();
    for (int kt = 0; kt < ntiles; ++kt) {
        const int cur = kt & 1;
        if (kt + 1 < ntiles) DA_LOAD((kt + 1) * 64);
        const LAS unsigned char* kb_ = lds + cur * KTILE; const LAS unsigned char* vb_ = lds + 2 * KTILE + cur * VTILE;
#pragma unroll
        for (int kc = 0; kc < 2; ++kc) {
            f32x4 sacc[2][2];
#pragma unroll
            for (int kb = 0; kb < 2; ++kb) {
                sacc[0][kb] = (f32x4){0.f, 0.f, 0.f, 0.f}; sacc[1][kb] = (f32x4){0.f, 0.f, 0.f, 0.f};
#pragma unroll
                for (int kh = 0; kh < KS / 2; ++kh) {
                    const bf16x8 k0 = *(const LAS bf16x8*)(kb_ + ((2 * kc + kb) * 16 + r16) * KROW + (2 * kh) * 64 + q4 * 16);
                    const bf16x8 k1 = *(const LAS bf16x8*)(kb_ + ((2 * kc + kb) * 16 + r16) * KROW + (2 * kh + 1) * 64 + q4 * 16);
                    __builtin_amdgcn_s_setprio(1);
                    sacc[0][kb] = MFMA16(k0, qf[0][2 * kh], sacc[0][kb]); sacc[1][kb] = MFMA16(k0, qf[1][2 * kh], sacc[1][kb]);
                    sacc[0][kb] = MFMA16(k1, qf[0][2 * kh + 1], sacc[0][kb]); sacc[1][kb] = MFMA16(k1, qf[1][2 * kh + 1], sacc[1][kb]);
                    __builtin_amdgcn_s_setprio(0);
                }
            }
            bf16x8 pb[2];
#pragma unroll
            for (int qg = 0; qg < 2; ++qg) {
                float mx = fmaxf(fmaxf(fmaxf(sacc[qg][0][0], sacc[qg][0][1]), fmaxf(sacc[qg][0][2], sacc[qg][0][3])), fmaxf(fmaxf(sacc[qg][1][0], sacc[qg][1][1]), fmaxf(sacc[qg][1][2], sacc[qg][1][3])));
                mx = fmaxf(mx, __shfl_xor(mx, 16)); mx = fmaxf(mx, __shfl_xor(mx, 32));
                const float mnew = fmaxf(mrun[qg], mx * sl2), alpha = fast_exp2(mrun[qg] - mnew);
                mrun[qg] = mnew;
                float ps = 0.f;
#pragma unroll
                for (int kb = 0; kb < 2; ++kb)
#pragma unroll
                    for (int j = 0; j < 4; ++j) { const float pv = fast_exp2(sacc[qg][kb][j] * sl2 - mnew); sacc[qg][kb][j] = pv; ps += pv; }
                lsum[qg] = lsum[qg] * alpha + ps;
#pragma unroll
                for (int d = 0; d < 8; ++d) oacc[qg][d] *= alpha;
                u32x4 w; w.x = cvt_pk_bf16(sacc[qg][0][0], sacc[qg][0][1]); w.y = cvt_pk_bf16(sacc[qg][0][2], sacc[qg][0][3]);
                w.z = cvt_pk_bf16(sacc[qg][1][0], sacc[qg][1][1]); w.w = cvt_pk_bf16(sacc[qg][1][2], sacc[qg][1][3]);
                pb[qg] = __builtin_bit_cast(bf16x8, w);
            }
#pragma unroll
            for (int dh = 0; dh < 4; ++dh) {
                bf16x8 vfr[2];
#pragma unroll
                for (int d4 = 0; d4 < 2; ++d4) {
                    const int d = dh * 2 + d4;
                    const u32x2 lo = *(const LAS u32x2*)(vb_ + (d * 16 + r16) * VROW + (kc * 32 + q4 * 4) * 2);
                    const u32x2 hi = *(const LAS u32x2*)(vb_ + (d * 16 + r16) * VROW + (kc * 32 + 16 + q4 * 4) * 2);
                    u32x4 w; w.x = lo.x; w.y = lo.y; w.z = hi.x; w.w = hi.y;
                    vfr[d4] = __builtin_bit_cast(bf16x8, w);
                }
                __builtin_amdgcn_s_setprio(1);
#pragma unroll
                for (int d4 = 0; d4 < 2; ++d4) { const int d = dh * 2 + d4; oacc[0][d] = MFMA16(vfr[d4], pb[0], oacc[0][d]); oacc[1][d] = MFMA16(vfr[d4], pb[1], oacc[1][d]); }
                __builtin_amdgcn_s_setprio(0);
            }
        }
        if (kt + 1 < ntiles) DA_STORE(cur ^ 1);
        __syncthreads();
    }
#pragma unroll
    for (int qg = 0; qg < 2; ++qg) {
        float l = lsum[qg]; l += __shfl_xor(l, 16); l += __shfl_xor(l, 32);
        const float inv = 1.f / l;
        bf16_t* op = Ob + (size_t)(wid * 32 + qg * 16 + r16) * DM + q4 * 4;
#pragma unroll
        for (int d = 0; d < 8; ++d) st_bf16x4(op + d * 16, oacc[qg][d] * inv);
    }
#undef DA_LOAD
#undef DA_STORE
}

DI void phase_dense_attn(const Params& p, int l, LAS unsigned char* lds) {
    unsigned char* ws = p.ws;
    const bf16_t* P = (const bf16_t*)(ws + WS_P); bf16_t* ymix = (bf16_t*)(ws + WS_YMIX);
    const int n_lat = 4 * 5 * 8, n_ctx = (l == 0) ? (20 + 24) : 0;
    for (int it = blockIdx.x; it < n_lat + n_ctx; it += gridDim.x) {
        if (it < n_lat) {
            const int qb = it & 7, h = (it >> 3) % 5, b = it / 40; const size_t rowb = (size_t)b * RB, row0 = rowb + CL + qb * 256;
            dense_attn_item<192>(lds, (const bf16_t*)(ws + WS_QM) + row0 * 960 + h * 192, 960, (const bf16_t*)(ws + WS_KM) + rowb * 640 + h * 128, 640, (const bf16_t*)(ws + WS_KPE) + rowb * 64,
                                 (const bf16_t*)(ws + WS_VTM) + ((size_t)b * 640 + h * 128) * RB, RB, 0.07216878364870322f * 1.4426950408889634f, ymix + row0 * DM + 768 + h * 128);
        } else if (it < n_lat + 20) {
            const int i2 = it - n_lat, h = i2 % 5, b = i2 / 5; const size_t rowb = (size_t)b * RB;
            dense_attn_item<192>(lds, (const bf16_t*)(ws + WS_QM) + rowb * 960 + h * 192, 960, (const bf16_t*)(ws + WS_KM) + rowb * 640 + h * 128, 640, (const bf16_t*)(ws + WS_KPE) + rowb * 64,
                                 (const bf16_t*)(ws + WS_VTM) + ((size_t)b * 640 + h * 128) * RB, CL, 0.07216878364870322f * 1.4426950408889634f, ymix + rowb * DM + 768 + h * 128);
        } else {
            const int i2 = it - n_lat - 20, h = i2 % 6, b = i2 / 6; const size_t rowb = (size_t)b * RB;
            dense_attn_item<128>(lds, P + rowb * INP + C_NAQ + h * 128, INP, P + rowb * INP + C_NAK + h * 128, INP, nullptr,
                                 (const bf16_t*)(ws + WS_VTNA) + ((size_t)b * 768 + h * 128) * RB, CL, 0.08838834764831845f * 1.4426950408889634f, ymix + rowb * DM + h * 128);
        }
    }
}

DI bf16x8 scale_bf16x8(bf16x8 v, const float* w) {
    u32x4 o;
    o.x = cvt_pk_bf16(bf2f((bf16_t)v[0]) * w[0], bf2f((bf16_t)v[1]) * w[1]); o.y = cvt_pk_bf16(bf2f((bf16_t)v[2]) * w[2], bf2f((bf16_t)v[3]) * w[3]);
    o.z = cvt_pk_bf16(bf2f((bf16_t)v[4]) * w[4], bf2f((bf16_t)v[5]) * w[5]); o.w = cvt_pk_bf16(bf2f((bf16_t)v[6]) * w[6], bf2f((bf16_t)v[7]) * w[7]);
    return __builtin_bit_cast(bf16x8, o);
}
DI bf16x8 scale1_bf16x8(bf16x8 v, float w) {
    u32x4 o;
    o.x = cvt_pk_bf16(bf2f((bf16_t)v[0]) * w, bf2f((bf16_t)v[1]) * w); o.y = cvt_pk_bf16(bf2f((bf16_t)v[2]) * w, bf2f((bf16_t)v[3]) * w);
    o.z = cvt_pk_bf16(bf2f((bf16_t)v[4]) * w, bf2f((bf16_t)v[5]) * w); o.w = cvt_pk_bf16(bf2f((bf16_t)v[6]) * w, bf2f((bf16_t)v[7]) * w);
    return __builtin_bit_cast(bf16x8, o);
}
DI float ret_lg2(const Params& p, int l, int dir, int h) { return log1pf(-exp2f(p.in[12][(l * 2 + dir) * 5 + h])) * 1.4426950408889634f; }

DI void phase_ret_scan(const Params& p, int l, LAS unsigned char* lds) {
    const int tid = otid(), lane = tid & 63, wid = tid >> 6, r16 = lane & 15, q4 = lane >> 4;
    unsigned char* ws = p.ws;
    volatile LAS int* slot = (volatile LAS int*)(lds + LDS_CTRL + 64);
    unsigned* ctr = (unsigned*)(ws + WS_QCTR + 256 * (3 + l));
    constexpr int VRS = RB * 2 + 16;
    for (;;) {
        const int it = next_item(ctr, slot);
        if (it >= 320) break;
        const int dvb = it & 7, dir = (it >> 3) & 1, h = (it >> 4) % 5, b = it / 80, dkb = wid;
        {
            const bf16_t* vsrc = (const bf16_t*)(ws + WS_VTR) + ((size_t)b * 640 + h * 128 + dvb * 16) * RB;
            u32x4 t[9];
#pragma unroll
            for (int i = 0; i < 9; ++i) { const int cid = tid + i * 512, rr = cid / 288, cc = cid % 288; t[i] = *(const u32x4*)(vsrc + (size_t)rr * RB + cc * 8); }
#pragma unroll
            for (int i = 0; i < 9; ++i) { const int cid = tid + i * 512, rr = cid / 288, cc = cid % 288; *(LAS u32x4*)(lds + rr * VRS + cc * 16) = t[i]; }
        }
        const float lg = ret_lg2(p, l, dir, h), gL = exp2f(lg * 128.f);
        float wt[4][8];
#pragma unroll
        for (int ks = 0; ks < 4; ++ks)
#pragma unroll
            for (int e = 0; e < 8; ++e) { const int pp = ks * 32 + q4 * 8 + e; wt[ks][e] = exp2f(lg * (float)(dir == 0 ? 127 - pp : pp)); }
        const bf16_t* kt = (const bf16_t*)(ws + WS_KTR) + ((size_t)b * 640 + h * 128 + dkb * 16 + r16) * RB + q4 * 8;
        const LAS unsigned char* vl = lds + r16 * VRS + q4 * 16;
        bf16_t* sb = (bf16_t*)(ws + WS_S) + ((size_t)((b * 5 + h) * 2 + dir) * 18) * 16384 + (dvb * 16 + r16) * 128 + dkb * 16 + q4 * 4;
        f32x4 st = (f32x4){0.f, 0.f, 0.f, 0.f};
        bf16x8 ca[4];
        { const int c0 = dir == 0 ? 0 : 1;
#pragma unroll
          for (int ks = 0; ks < 4; ++ks) ca[ks] = *(const bf16x8*)(kt + c0 * 128 + ks * 32); }
        __syncthreads();
#pragma unroll 2
        for (int step = 0; step < 18; ++step) {
            const int c = dir == 0 ? step : (step < 2 ? 1 - step : 19 - step);
            const int sn = step < 17 ? step + 1 : 17;
            const int cn = dir == 0 ? sn : (sn < 2 ? 1 - sn : 19 - sn);
            bf16x8 na_[4];
#pragma unroll
            for (int ks = 0; ks < 4; ++ks) na_[ks] = *(const bf16x8*)(kt + cn * 128 + ks * 32);
            st_bf16x4(sb + (size_t)c * 16384, st);
            f32x4 u = (f32x4){0.f, 0.f, 0.f, 0.f};
#pragma unroll
            for (int ks = 0; ks < 4; ++ks) u = MFMA16(scale_bf16x8(ca[ks], wt[ks]), *(const LAS bf16x8*)(vl + (c * 128 + ks * 32) * 2), u);
            st = st * gL + u;
#pragma unroll
            for (int ks = 0; ks < 4; ++ks) ca[ks] = na_[ks];
        }
    }
}

DI void ret_out_item(const Params& p, int l, int b, int h, int c, LAS unsigned char* lds) {
    const int tid = otid(), lane = tid & 63, wid = tid >> 6, r16 = lane & 15, q4 = lane >> 4;
    unsigned char* ws = p.ws;
    const bf16_t* P = (const bf16_t*)(ws + WS_P);
    const float lgf = ret_lg2(p, l, 0, h), lgb = ret_lg2(p, l, 1, h);
    const size_t rowb = (size_t)b * RB; const int tok0 = c * 128, tl = wid * 16 + r16;
    const size_t row = rowb + tok0 + tl;
    constexpr int RS = 272, MB = 128 * RS;
    {
        const bf16_t* Sf = (const bf16_t*)(ws + WS_S) + ((size_t)((b * 5 + h) * 2 + 0) * 18 + c) * 16384;
        const bf16_t* Sb = (const bf16_t*)(ws + WS_S) + ((size_t)((b * 5 + h) * 2 + 1) * 18 + c) * 16384;
        const bf16_t* Kc = P + (rowb + tok0) * INP + C_RK + h * 128;
        const bf16_t* Vc = (const bf16_t*)(ws + WS_VTR) + ((size_t)b * 640 + h * 128) * RB + tok0;
        u32x4 t0[4], t1[4], t2[4], t3[4];
#pragma unroll
        for (int i = 0; i < 4; ++i) {
            const int cid = tid + i * 512, rr = cid >> 4, cc = cid & 15;
            t0[i] = *(const u32x4*)(Sf + rr * 128 + cc * 8); t1[i] = *(const u32x4*)(Sb + rr * 128 + cc * 8);
            t2[i] = *(const u32x4*)(Kc + (size_t)rr * INP + cc * 8); t3[i] = *(const u32x4*)(Vc + (size_t)rr * RB + cc * 8);
        }
#pragma unroll
        for (int i = 0; i < 4; ++i) {
            const int cid = tid + i * 512, rr = cid >> 4, cc = cid & 15;
            *(LAS u32x4*)(lds + 0 * MB + rr * RS + cc * 16) = t0[i]; *(LAS u32x4*)(lds + 1 * MB + rr * RS + cc * 16) = t1[i];
            *(LAS u32x4*)(lds + 2 * MB + rr * RS + cc * 16) = t2[i]; *(LAS u32x4*)(lds + 3 * MB + rr * RS + cc * 16) = t3[i];
        }
    }
    bf16x8 qf[4], qff[4], qfb[4];
    const float qdf = exp2f(lgf * (float)(tl + 1)), qdb = exp2f(lgb * (float)(128 - tl));
#pragma unroll
    for (int ks = 0; ks < 4; ++ks) { qf[ks] = *(const bf16x8*)(P + row * INP + C_RQ + h * 128 + ks * 32 + q4 * 8); qff[ks] = scale1_bf16x8(qf[ks], qdf); qfb[ks] = scale1_bf16x8(qf[ks], qdb); }
    f32x4 oacc[8];
#pragma unroll
    for (int d = 0; d < 8; ++d) oacc[d] = (f32x4){0.f, 0.f, 0.f, 0.f};
    __syncthreads();
    const LAS unsigned char* sfp = lds + 0 * MB + r16 * RS + q4 * 16;
    const LAS unsigned char* sbp = lds + 1 * MB + r16 * RS + q4 * 16;
    const LAS unsigned char* kcp = lds + 2 * MB + r16 * RS + q4 * 16;
    const LAS unsigned char* vtp = lds + 3 * MB + r16 * RS + q4 * 8;
#pragma unroll
    for (int d = 0; d < 8; ++d)
#pragma unroll
        for (int ks = 0; ks < 4; ++ks) {
            oacc[d] = MFMA16(*(const LAS bf16x8*)(sfp + d * 16 * RS + ks * 64), qff[ks], oacc[d]);
            oacc[d] = MFMA16(*(const LAS bf16x8*)(sbp + d * 16 * RS + ks * 64), qfb[ks], oacc[d]);
        }
#pragma unroll
    for (int kc = 0; kc < 4; ++kc) {
        f32x4 s[2];
#pragma unroll
        for (int hf = 0; hf < 2; ++hf) {
            s[hf] = (f32x4){0.f, 0.f, 0.f, 0.f};
#pragma unroll
            for (int ks = 0; ks < 4; ++ks) s[hf] = MFMA16(*(const LAS bf16x8*)(kcp + (2 * kc + hf) * 16 * RS + ks * 64), qf[ks], s[hf]);
#pragma unroll
            for (int j = 0; j < 4; ++j) {
                const int m = (2 * kc + hf) * 16 + q4 * 4 + j, d = tl - m;
                const float w = (d >= 0 ? exp2f(lgf * (float)d) : 0.f) + (d <= 0 ? exp2f(-lgb * (float)d) : 0.f);
                s[hf][j] *= w;
            }
        }
        u32x4 w4; w4.x = cvt_pk_bf16(s[0][0], s[0][1]); w4.y = cvt_pk_bf16(s[0][2], s[0][3]); w4.z = cvt_pk_bf16(s[1][0], s[1][1]); w4.w = cvt_pk_bf16(s[1][2], s[1][3]);
        const bf16x8 pb = __builtin_bit_cast(bf16x8, w4);
#pragma unroll
        for (int d = 0; d < 8; ++d) {
            const u32x2 lo = *(const LAS u32x2*)(vtp + d * 16 * RS + kc * 64), hi = *(const LAS u32x2*)(vtp + d * 16 * RS + kc * 64 + 32);
            u32x4 a4; a4.x = lo.x; a4.y = lo.y; a4.z = hi.x; a4.w = hi.y;
            oacc[d] = MFMA16(__builtin_bit_cast(bf16x8, a4), pb, oacc[d]);
        }
    }
    float sum = 0.f;
#pragma unroll
    for (int d = 0; d < 8; ++d) sum += oacc[d][0] + oacc[d][1] + oacc[d][2] + oacc[d][3];
    sum += __shfl_xor(sum, 16); sum += __shfl_xor(sum, 32);
    const float mu = sum * (1.f / 128.f);
    float sq = 0.f;
#pragma unroll
    for (int d = 0; d < 8; ++d) { oacc[d] -= mu; sq += oacc[d][0] * oacc[d][0] + oacc[d][1] * oacc[d][1] + oacc[d][2] * oacc[d][2] + oacc[d][3] * oacc[d][3]; }
    sq += __shfl_xor(sq, 16); sq += __shfl_xor(sq, 32);
    const float rs = rsqrtf(sq * (1.f / 128.f) + 1e-5f);
    const bf16_t* gp = P + row * INP + C_RG + h * 128 + q4 * 4;
    bf16_t* op = (bf16_t*)(ws + WS_YMIX) + row * DM + 1408 + h * 128 + q4 * 4;
#pragma unroll
    for (int d = 0; d < 8; ++d) {
        const u32x2 g2 = *(const u32x2*)(gp + d * 16);
        f32x4 g; g[0] = __uint_as_float(g2.x << 16); g[1] = __uint_as_float(g2.x & 0xffff0000u); g[2] = __uint_as_float(g2.y << 16); g[3] = __uint_as_float(g2.y & 0xffff0000u);
        f32x4 y;
#pragma unroll
        for (int j = 0; j < 4; ++j) y[j] = oacc[d][j] * rs * silu(g[j]);
        st_bf16x4(op + d * 16, y);
    }
}


DI void na_item(const Params& p, int l, int b, int h, int gr, int jq, int lane) {
    const int r16 = lane & 15, q4 = lane >> 4;
    unsigned char* ws = p.ws;
    const bf16_t* P = (const bf16_t*)(ws + WS_P);
    const int gc = jq * 16 + r16, r0 = min(max(gr - 4, 0), 24), band = min(max(jq * 16 - 8, 0), 32), cs = min(max(gc - 8, 0), 48);
    const size_t rowb = (size_t)b * RB, rowq = rowb + CL + gr * 64 + gc;
    const float sl2 = 0.08838834764831845f * 1.4426950408889634f;
    const float* rpb = p.in[11] + (size_t)(l * 6 + h) * 15 * 31;
    bf16x8 qf[4];
#pragma unroll
    for (int ks = 0; ks < 4; ++ks) qf[ks] = *(const bf16x8*)(P + rowq * INP + C_NAQ + h * 128 + ks * 32 + q4 * 8);
    f32x4 oacc[8];
#pragma unroll
    for (int d = 0; d < 8; ++d) oacc[d] = (f32x4){0.f, 0.f, 0.f, 0.f};
    float mrun = -1e30f, lsum = 0.f;
    const bf16_t* vtb = (const bf16_t*)(ws + WS_VTNA) + ((size_t)b * 768 + h * 128 + r16) * RB + q4 * 4;
    const bf16_t* kbase = P + (rowb + r16) * INP + C_NAK + h * 128 + q4 * 8;
    const int tb0 = CL + r0 * 64 + band;
    bf16x8 kf[2][4];
#pragma unroll
    for (int hf = 0; hf < 2; ++hf)
#pragma unroll
        for (int ks = 0; ks < 4; ++ks) kf[hf][ks] = *(const bf16x8*)(kbase + (size_t)(tb0 + hf * 16) * INP + ks * 32);
#pragma unroll 2
    for (int ch = 0; ch < 16; ++ch) {
        const int tokbase = ch < 8 ? tb0 + ch * 64 : (ch - 8) * 32;
        const int chn = ch < 15 ? ch + 1 : 15;
        const int tokn = chn < 8 ? tb0 + chn * 64 : (chn - 8) * 32;
        u32x2 vlo[8], vhi[8];
#pragma unroll
        for (int d = 0; d < 8; ++d) { vlo[d] = *(const u32x2*)(vtb + (size_t)(d * 16) * RB + tokbase); vhi[d] = *(const u32x2*)(vtb + (size_t)(d * 16) * RB + tokbase + 16); }
        bf16x8 kn[2][4];
#pragma unroll
        for (int hf = 0; hf < 2; ++hf)
#pragma unroll
            for (int ks = 0; ks < 4; ++ks) kn[hf][ks] = *(const bf16x8*)(kbase + (size_t)(tokn + hf * 16) * INP + ks * 32);
        f32x4 s[2];
#pragma unroll
        for (int hf = 0; hf < 2; ++hf) {
            s[hf] = (f32x4){0.f, 0.f, 0.f, 0.f};
#pragma unroll
            for (int ks = 0; ks < 4; ++ks) s[hf] = MFMA16(kf[hf][ks], qf[ks], s[hf]);
        }
        if (ch < 8) {
            const float* rp = rpb + (r0 + ch - gr + 7) * 31;
#pragma unroll
            for (int hf = 0; hf < 2; ++hf)
#pragma unroll
                for (int j = 0; j < 4; ++j) {
                    const int kcol = band + hf * 16 + q4 * 4 + j; const bool inw = kcol >= cs && kcol < cs + 16;
                    const float bias = rp[min(max(kcol - gc + 15, 0), 30)];
                    s[hf][j] = inw ? s[hf][j] * sl2 + bias * 1.4426950408889634f : -1e30f;
                }
        } else { s[0] *= sl2; s[1] *= sl2; }
        float mx = fmaxf(fmaxf(fmaxf(s[0][0], s[0][1]), fmaxf(s[0][2], s[0][3])), fmaxf(fmaxf(s[1][0], s[1][1]), fmaxf(s[1][2], s[1][3])));
        mx = fmaxf(mx, __shfl_xor(mx, 16)); mx = fmaxf(mx, __shfl_xor(mx, 32));
        const float mnew = fmaxf(mrun, mx), alpha = fast_exp2(mrun - mnew);
        mrun = mnew;
        float ps = 0.f;
#pragma unroll
        for (int hf = 0; hf < 2; ++hf)
#pragma unroll
            for (int j = 0; j < 4; ++j) { const float pv = fast_exp2(s[hf][j] - mnew); s[hf][j] = pv; ps += pv; }
        lsum = lsum * alpha + ps;
#pragma unroll
        for (int d = 0; d < 8; ++d) oacc[d] *= alpha;
        u32x4 w4; w4.x = cvt_pk_bf16(s[0][0], s[0][1]); w4.y = cvt_pk_bf16(s[0][2], s[0][3]); w4.z = cvt_pk_bf16(s[1][0], s[1][1]); w4.w = cvt_pk_bf16(s[1][2], s[1][3]);
        const bf16x8 pb = __builtin_bit_cast(bf16x8, w4);
#pragma unroll
        for (int d = 0; d < 8; ++d) {
            u32x4 a4; a4.x = vlo[d].x; a4.y = vlo[d].y; a4.z = vhi[d].x; a4.w = vhi[d].y;
            oacc[d] = MFMA16(__builtin_bit_cast(bf16x8, a4), pb, oacc[d]);
        }
#pragma unroll
        for (int hf = 0; hf < 2; ++hf)
#pragma unroll
            for (int ks = 0; ks < 4; ++ks) kf[hf][ks] = kn[hf][ks];
    }
    float lt = lsum; lt += __shfl_xor(lt, 16); lt += __shfl_xor(lt, 32);
    const float inv = 1.f / lt;
    bf16_t* op = (bf16_t*)(ws + WS_YMIX) + rowq * DM + h * 128 + q4 * 4;
#pragma unroll
    for (int d = 0; d < 8; ++d) st_bf16x4(op + d * 16, oacc[d] * inv);
}

DI void na_block_item(const Params& p, int l, int b, int h, int rp, LAS unsigned char* lds) {
    const int tid = otid(), lane = tid & 63, wid = tid >> 6, r16 = lane & 15, q4 = lane >> 4;
    unsigned char* ws = p.ws;
    const bf16_t* P = (const bf16_t*)(ws + WS_P);
    constexpr int KROW = 272, KTILE = 64 * KROW, VROW = 144, VTILE = 128 * VROW;
    const int gr = 2 * rp + (wid >> 2), jq = wid & 3;
    const int gc = jq * 16 + r16, r0w = min(max(gr - 4, 0), 24), band = min(max(jq * 16 - 8, 0), 32), cs = min(max(gc - 8, 0), 48);
    const int r0a = min(max(2 * rp - 4, 0), 24), r0b = min(max(2 * rp - 3, 0), 24), nloc = r0b + 8 - r0a, ntl = nloc + 4;
    const size_t rowb = (size_t)b * RB, rowq = rowb + CL + gr * 64 + gc;
    const float sl2 = 0.08838834764831845f * 1.4426950408889634f;
    const float* rpb = p.in[11] + (size_t)(l * 6 + h) * 15 * 31;
    bf16x8 qf[4];
#pragma unroll
    for (int ks = 0; ks < 4; ++ks) qf[ks] = *(const bf16x8*)(P + rowq * INP + C_NAQ + h * 128 + ks * 32 + q4 * 8);
    f32x4 oacc[8];
#pragma unroll
    for (int d = 0; d < 8; ++d) oacc[d] = (f32x4){0.f, 0.f, 0.f, 0.f};
    float mrun = -1e30f, lsum = 0.f;
    const bf16_t* kg = P + rowb * INP + C_NAK + h * 128;
    const bf16_t* vg = (const bf16_t*)(ws + WS_VTNA) + ((size_t)b * 768 + h * 128) * RB;
    u32x4 kstA[2], vstA[2], kstB[2], vstB[2];
#define NA_TB(t) ((t) < nloc ? CL + (r0a + (t)) * 64 : ((t) - nloc) * 64)
#define NA_LOAD(t, ks_, vs_) do { const int tb_ = NA_TB(t); \
        _Pragma("unroll") for (int i = 0; i < 2; ++i) { const int cid = tid + i * 512; \
            ks_[i] = *(const u32x4*)(kg + (size_t)(tb_ + (cid >> 4)) * INP + (cid & 15) * 8); \
            vs_[i] = *(const u32x4*)(vg + (size_t)(cid >> 3) * RB + tb_ + (cid & 7) * 8); } } while (0)
#define NA_STORE(buf, ks_, vs_) do { \
        _Pragma("unroll") for (int i = 0; i < 2; ++i) { const int cid = tid + i * 512; \
            *(LAS u32x4*)(lds + (buf) * KTILE + (cid >> 4) * KROW + (cid & 15) * 16) = ks_[i]; \
            *(LAS u32x4*)(lds + 3 * KTILE + (buf) * VTILE + (cid >> 3) * VROW + (cid & 7) * 16) = vs_[i]; } } while (0)
    LAS float* s_rpb = (LAS float*)(lds + 3 * KTILE + 3 * VTILE);
    if (tid < 465) s_rpb[tid] = rpb[tid];
    NA_LOAD(0, kstA, vstA); NA_LOAD(1, kstB, vstB);
    NA_STORE(0, kstA, vstA);
    NA_LOAD(2, kstA, vstA);
    __syncthreads();
    for (int t = 0; t < ntl; ++t) {
        const int cur = t % 3;
        const bool local = t < nloc; const int kr = r0a + t;
        const int nch = local ? ((kr >= r0w && kr < r0w + 8) ? 1 : 0) : 2;
        for (int ci = 0; ci < nch; ++ci) {
            const int toff = local ? band : ci * 32;
            const LAS unsigned char* kb_ = lds + cur * KTILE + (toff + r16) * KROW + q4 * 16;
            const LAS unsigned char* vb_ = lds + 3 * KTILE + cur * VTILE + r16 * VROW + (toff + q4 * 4) * 2;
            float bias8[8];
            if (local) {
                const LAS float* rp_ = s_rpb + (kr - gr + 7) * 31;
#pragma unroll
                for (int e = 0; e < 8; ++e) { const int kcol = band + (e >> 2) * 16 + q4 * 4 + (e & 3); bias8[e] = rp_[min(max(kcol - gc + 15, 0), 30)]; }
            }
            f32x4 s[2];
#pragma unroll
            for (int hf = 0; hf < 2; ++hf) {
                s[hf] = (f32x4){0.f, 0.f, 0.f, 0.f};
#pragma unroll
                for (int ks = 0; ks < 4; ++ks) s[hf] = MFMA16(*(const LAS bf16x8*)(kb_ + hf * 16 * KROW + ks * 64), qf[ks], s[hf]);
            }
            if (local) {
#pragma unroll
                for (int hf = 0; hf < 2; ++hf)
#pragma unroll
                    for (int j = 0; j < 4; ++j) {
                        const int kcol = band + hf * 16 + q4 * 4 + j; const bool inw = kcol >= cs && kcol < cs + 16;
                        s[hf][j] = inw ? s[hf][j] * sl2 + bias8[hf * 4 + j] * 1.4426950408889634f : -1e30f;
                    }
            } else { s[0] *= sl2; s[1] *= sl2; }
            float mx = fmaxf(fmaxf(fmaxf(s[0][0], s[0][1]), fmaxf(s[0][2], s[0][3])), fmaxf(fmaxf(s[1][0], s[1][1]), fmaxf(s[1][2], s[1][3])));
            mx = fmaxf(mx, __shfl_xor(mx, 16)); mx = fmaxf(mx, __shfl_xor(mx, 32));
            const float mnew = fmaxf(mrun, mx), alpha = fast_exp2(mrun - mnew);
            mrun = mnew;
            float ps = 0.f;
#pragma unroll
            for (int hf = 0; hf < 2; ++hf)
#pragma unroll
                for (int j = 0; j < 4; ++j) { const float pv = fast_exp2(s[hf][j] - mnew); s[hf][j] = pv; ps += pv; }
            lsum = lsum * alpha + ps;
#pragma unroll
            for (int d = 0; d < 8; ++d) oacc[d] *= alpha;
            u32x4 w4; w4.x = cvt_pk_bf16(s[0][0], s[0][1]); w4.y = cvt_pk_bf16(s[0][2], s[0][3]); w4.z = cvt_pk_bf16(s[1][0], s[1][1]); w4.w = cvt_pk_bf16(s[1][2], s[1][3]);
            const bf16x8 pb = __builtin_bit_cast(bf16x8, w4);
            __builtin_amdgcn_s_setprio(1);
#pragma unroll
            for (int d = 0; d < 8; ++d) {
                const u32x2 lo = *(const LAS u32x2*)(vb_ + d * 16 * VROW), hi = *(const LAS u32x2*)(vb_ + d * 16 * VROW + 32);
                u32x4 a4; a4.x = lo.x; a4.y = lo.y; a4.z = hi.x; a4.w = hi.y;
                oacc[d] = MFMA16(__builtin_bit_cast(bf16x8, a4), pb, oacc[d]);
            }
            __builtin_amdgcn_s_setprio(0);
        }
        const int nb_ = (t + 1) % 3;
        if (t & 1) { if (t + 1 < ntl) NA_STORE(nb_, kstA, vstA); if (t + 3 < ntl) NA_LOAD(t + 3, kstA, vstA); }
        else       { if (t + 1 < ntl) NA_STORE(nb_, kstB, vstB); if (t + 3 < ntl) NA_LOAD(t + 3, kstB, vstB); }
        __syncthreads();
    }
#undef NA_TB
#undef NA_LOAD
#undef NA_STORE
    float lt = lsum; lt += __shfl_xor(lt, 16); lt += __shfl_xor(lt, 32);
    const float inv = 1.f / lt;
    bf16_t* op = (bf16_t*)(ws + WS_YMIX) + rowq * DM + h * 128 + q4 * 4;
#pragma unroll
    for (int d = 0; d < 8; ++d) st_bf16x4(op + d * 16, oacc[d] * inv);
}

DI void dense192_item(unsigned char* ws, LAS unsigned char* lds, int b, int h, int q0, int nk) {
    const size_t rowb = (size_t)b * RB, row0 = rowb + q0;
    dense_attn_item<192>(lds, (const bf16_t*)(ws + WS_QM) + row0 * 960 + h * 192, 960, (const bf16_t*)(ws + WS_KM) + rowb * 640 + h * 128, 640, (const bf16_t*)(ws + WS_KPE) + rowb * 64,
                         (const bf16_t*)(ws + WS_VTM) + ((size_t)b * 640 + h * 128) * RB, nk, 0.07216878364870322f * 1.4426950408889634f, (bf16_t*)(ws + WS_YMIX) + row0 * DM + 768 + h * 128);
}
DI void phase_mixers(const Params& p, int l, LAS unsigned char* lds) {
    unsigned char* ws = p.ws;
    volatile LAS int* slot = (volatile LAS int*)(lds + LDS_CTRL + 64);
    unsigned* ctr = (unsigned*)(ws + WS_QCTR + 256 * (1 + l));
    const int nc = (l == 0) ? 18 : 16, n_ro = 20 * nc, n_na = 384, n_ctx = (l == 0) ? 44 : 0;
    const int e0 = 160, e1 = e0 + n_ro, e2 = e1 + n_na, e3 = e2 + n_ctx;
    int it = next_item(ctr, slot);
    while (it < e0) { dense192_item(ws, lds, it / 40, (it >> 3) % 5, CL + (it & 7) * 256, RB); it = next_item(ctr, slot); }
    while (it < e1) { const int i2 = it - e0, c = (i2 % nc) + (18 - nc), bh = i2 / nc; ret_out_item(p, l, bh / 5, bh % 5, c, lds); it = next_item(ctr, slot); }
    while (it < e2) { const int i2 = it - e1; na_block_item(p, l, i2 / 96, (i2 >> 4) % 6, i2 & 15, lds); it = next_item(ctr, slot); }
    if (l == 0) {
        while (it < e2 + 20) { const int i2 = it - e2; dense192_item(ws, lds, i2 / 5, i2 % 5, 0, CL); it = next_item(ctr, slot); }
        while (it < e3) {
            const int i2 = it - e2 - 20, h = i2 % 6, b = i2 / 6; const size_t rowb = (size_t)b * RB;
            const bf16_t* P = (const bf16_t*)(ws + WS_P);
            dense_attn_item<128>(lds, P + rowb * INP + C_NAQ + h * 128, INP, P + rowb * INP + C_NAK + h * 128, INP, nullptr,
                                 (const bf16_t*)(ws + WS_VTNA) + ((size_t)b * 768 + h * 128) * RB, CL, 0.08838834764831845f * 1.4426950408889634f, (bf16_t*)(ws + WS_YMIX) + rowb * DM + h * 128);
            it = next_item(ctr, slot);
        }
    }
}

#define IN(k) (true)
#define SEAM(k) do { if ((k) != 19) xcd_barrier(bar); } while (0)
template <int L>
DI void layer_body(const Params& p, LAS unsigned char* lds, cg::grid_group& grid, const XcdBarrier& bar) {
        constexpr int l = L; constexpr int pb = 2 + 9 * l; constexpr bool last = (l == 1);
        unsigned char* ws = p.ws; asm volatile("" : "+s"(ws));
        const float* mod = (const float*)(ws + WS_MOD);
        if (IN(pb + 0)) {
            Sched S; S.init(36, 24, 0); EpiInproj E{ws, lds + 131072};
            gemm_phase(lds, (const bf16_t*)(ws + WS_H), DM, (const bf16_t*)(ws + WS_WIN) + (size_t)l * 6144 * 2048, 2048, S, E);
            SEAM(pb + 0);
        }
        if (IN(pb + 1)) {
            { Sched S; S.init(36, 4, 0); EpiQup E{ws}; gemm_phase(lds, (const bf16_t*)(ws + WS_P) + C_CQ, INP, (const bf16_t*)(ws + WS_WUQ) + (size_t)l * 1024 * 512, 512, S, E); }
            { Sched S; S.init(36, 5, 0); EpiKVup E{ws}; gemm_phase(lds, (const bf16_t*)(ws + WS_P) + C_CKV, INP, (const bf16_t*)(ws + WS_WUKV) + (size_t)l * 1280 * 512, 512, S, E); }
            phase_ret_scan(p, l, lds);
            SEAM(pb + 1);
        }
        if (IN(pb + 2)) { phase_mixers(p, l, lds); SEAM(pb + 2); }
        if (IN(pb + 3)) {
            Sched S; S.init(32, 8, 1, last ? 0 : 1); EpiResid E{ws, mod + (size_t)(l * 5) * 12288 + 2 * 2048, l == 0 ? nullptr : p.in[20], l == 0 ? nullptr : p.in[21]};
            gemm_phase(lds, (const bf16_t*)(ws + WS_YMIX), DM, (const bf16_t*)(ws + WS_WO) + (size_t)l * 2048 * 2048, 2048, S, E);
            SEAM(pb + 3);
        }
        if (IN(pb + 4)) { phase_ln(p, p.in[14] + l * DM, p.in[15] + l * DM, mod + (size_t)(l * 5) * 12288 + 3 * 2048, last, false, last ? nullptr : mod + (size_t)(l * 5 + 4) * 12288 + 2 * 2048, nullptr, nullptr); SEAM(pb + 4); }
        if (IN(pb + 5)) {
            Sched S; S.init(last ? 32 : 36, 44, last); EpiUpGlu E{ws, p.in[17] + (size_t)l * 3 * DFF, p.in[18] + (size_t)l * DFF};
            gemm_phase<EpiUpGlu, true>(lds, (const bf16_t*)(ws + WS_H), DM, (const bf16_t*)(ws + WS_WUP) + (size_t)l * 11264 * 2048, 2048, S, E);
            SEAM(pb + 5);
        }
        if (IN(pb + 7)) {
            Sched S; S.init(32, 8, 1, last ? 0 : 1); EpiResid E{ws, mod + (size_t)(l * 5) * 12288 + 5 * 2048, p.in[14] + l * DM, p.in[15] + l * DM};
            { Unit u0; for (int i = 0; i < 2; ++i) if (S.next(i, u0)) glu_fix_panel(p, l, u0.pm);
              asm volatile("s_waitcnt vmcnt(0)" ::: "memory"); __syncthreads(); }
            gemm_phase(lds, (const bf16_t*)(ws + WS_G), DFF, (const bf16_t*)(ws + WS_WDN) + (size_t)l * 2048 * 5632, 5632, S, E);
            SEAM(pb + 7);
        }
        if (IN(pb + 8)) { phase_ln(p, p.in[20] + l * DM, p.in[21] + l * DM, mod + (size_t)((last ? 0 : l + 1) * 5) * 12288, last, last, last ? nullptr : mod + (size_t)(l * 5 + 4) * 12288 + 5 * 2048, p.in[14] + l * DM, p.in[15] + l * DM); SEAM(pb + 8); }
    }

__global__ void __launch_bounds__(512, 2) fwd_kernel(Params p) {
    extern __shared__ __attribute__((aligned(16))) unsigned char smem[];
    LAS unsigned char* lds = (LAS unsigned char*)smem;
    cg::grid_group grid = cg::this_grid();
    if (threadIdx.x < 32) ((volatile LAS unsigned*)(lds + LDS_CTRL))[threadIdx.x] = 0u;
    __syncthreads();
    const XcdBarrier bar = xcd_barrier_post((unsigned*)(p.ws + WS_CTL), (volatile LAS unsigned*)(lds + LDS_CTRL));
    if (p.ph_lo == 0x7fffffff) grid.sync();
    if (IN(0)) { phase_prep(p, lds); xcd_barrier(bar); }
    if (IN(1)) { phase_init_x(p); SEAM(1); }
    layer_body<0>(p, lds, grid, bar);
    layer_body<1>(p, lds, grid, bar);
}

extern "C" void kernel_launch(void* const* d_in, const int* in_sizes, int n_in, void* d_out, int out_size, void* d_ws, size_t ws_size, hipStream_t stream) {
    static int grid = 0;
    if (grid == 0) {
        if (n_in != 22 || ws_size < WS_END) { fprintf(stderr, "kernel_launch: need 22 inputs and %zu bytes of workspace (got %d, %zu)\n", (size_t)WS_END, n_in, ws_size); grid = -1; return; }
        int dev = 0, cus = 0, per_cu = 0;
        hipGetDevice(&dev); hipDeviceGetAttribute(&cus, hipDeviceAttributeMultiprocessorCount, dev);
        if (hipFuncSetAttribute((const void*)fwd_kernel, hipFuncAttributeMaxDynamicSharedMemorySize, LDS_BYTES) != hipSuccess) { fprintf(stderr, "kernel_launch: hipFuncSetAttribute failed\n"); grid = -1; return; }
        hipOccupancyMaxActiveBlocksPerMultiprocessor(&per_cu, (const void*)fwd_kernel, 512, LDS_BYTES);
        if (per_cu < 1) { fprintf(stderr, "kernel_launch: occupancy query says %d blocks per CU\n", per_cu); per_cu = 1; }
        grid = cus * 1;
        (void)hipGetLastError();
    }
    if (grid < 0) return;
    if (hipMemsetAsync((char*)d_ws + WS_CTL, 0, CTL_BYTES, stream) != hipSuccess) { fprintf(stderr, "kernel_launch: memset failed\n"); return; }
    Params p{};
    for (int i = 0; i < 22; ++i) p.in[i] = (const float*)d_in[i];
    p.out = (float*)d_out; p.ws = (unsigned char*)d_ws; p.ph_lo = 0; p.ph_hi = 20;
    void* args[] = {&p};
    hipError_t e = hipLaunchCooperativeKernel((const void*)fwd_kernel, dim3(grid), dim3(512), args, LDS_BYTES, stream);
    if (e != hipSuccess) fprintf(stderr, "cooperative launch failed: %s (grid %d)\n", hipGetErrorString(e), grid);
}
```

```cpp
#include <hip/hip_runtime.h>
#include <hip/hip_cooperative_groups.h>
#include <cstdio>
namespace cg = cooperative_groups;

#define LAS __attribute__((address_space(3)))
#define DI __device__ __forceinline__
typedef unsigned short bf16_t;
typedef short bf16x8 __attribute__((ext_vector_type(8)));
typedef float f32x4 __attribute__((ext_vector_type(4)));
typedef float f32x2 __attribute__((ext_vector_type(2)));
typedef unsigned u32x2 __attribute__((ext_vector_type(2)));
typedef unsigned u32x4 __attribute__((ext_vector_type(4)));

constexpr int DM = 2048, TL = 2048, CL = 256, RB = 2304, MR = 9216;
constexpr int INW = 5952, INP = 6144, DFF = 5632;
constexpr int C_NAQ = 0, C_NAK = 768, C_NAV = 1536, C_CQ = 2304, C_CKV = 2816, C_KPE = 3328, C_RQ = 3392, C_RK = 4032, C_RV = 4672, C_RG = 5312;
constexpr float ALPHA = 1.4142135623730951f;

constexpr size_t al(size_t x) { return (x + 255) & ~(size_t)255; }
constexpr size_t WS_CTL = 0;
constexpr size_t CTL_BYTES = 32768;
constexpr size_t WS_QCTR = 16384;
constexpr size_t WS_MOD = CTL_BYTES;
constexpr size_t WS_TABM = al(WS_MOD + 2ull * 5 * 12288 * 4);
constexpr size_t WS_TABR = al(WS_TABM + 2048ull * 32 * 8);
constexpr size_t WS_SSQ = al(WS_TABR + 2048ull * 64 * 8);
constexpr size_t WS_WIN = al(WS_SSQ + 9216ull * 32 * 4);
constexpr size_t WS_WUQ = al(WS_WIN + 2ull * 6144 * 2048 * 2);
constexpr size_t WS_WUKV = al(WS_WUQ + 2ull * 1024 * 512 * 2);
constexpr size_t WS_WO = al(WS_WUKV + 2ull * 1280 * 512 * 2);
constexpr size_t WS_WUP = al(WS_WO + 2ull * 2048 * 2048 * 2);
constexpr size_t WS_WDN = al(WS_WUP + 2ull * 11264 * 2048 * 2);
constexpr size_t WS_X = al(WS_WDN + 2ull * 2048 * 5632 * 2);
constexpr size_t WS_AU = al(WS_X + 9216ull * 2048 * 4);
constexpr size_t WS_G = al(WS_AU + 9216ull * 11264 * 2);
constexpr size_t WS_H = al(WS_G + 9216ull * 5632 * 2);
constexpr size_t WS_RSTAT = al(WS_H + 9216ull * 2048 * 2);
constexpr size_t WS_END = al(WS_RSTAT + 9216ull * 8);
constexpr size_t WS_EDGE = WS_AU;
constexpr size_t WS_PART = WS_AU + (16ull << 20);
constexpr size_t WS_P = WS_AU;
constexpr size_t WS_VTNA = al(WS_P + 9216ull * 6144 * 2);
constexpr size_t WS_VTR = al(WS_VTNA + 4ull * 768 * 2304 * 2);
constexpr size_t WS_KTR = al(WS_VTR + 4ull * 640 * 2304 * 2);
constexpr size_t WS_QM = al(WS_KTR + 4ull * 640 * 2304 * 2);
constexpr size_t WS_KM = al(WS_QM + 9216ull * 960 * 2);
constexpr size_t WS_VTM = al(WS_KM + 9216ull * 640 * 2);
constexpr size_t WS_KPE = al(WS_VTM + 4ull * 640 * 2304 * 2);
constexpr size_t WS_KTRB = al(WS_KPE + 9216ull * 64 * 2);
static_assert(al(WS_KTRB + 4ull * 640 * 2304 * 2) <= WS_G, "mixer scratch must fit under AU");
constexpr size_t WS_YMIX = WS_G;
constexpr size_t WS_S = al(WS_YMIX + 9216ull * 2048 * 2);
static_assert(al(WS_S + 4ull * 5 * 2 * 18 * 128 * 128 * 2) <= WS_H, "G region too small");

constexpr int LDS_CTRL = 139264;
constexpr int LDS_BYTES = LDS_CTRL + 1024;

struct Params { const float* in[22]; float* out; unsigned char* ws; int ph_lo, ph_hi; };

DI bf16_t f2bf(float x) { unsigned u = __float_as_uint(x); u += 0x7fffu + ((u >> 16) & 1u); return (bf16_t)(u >> 16); }
DI float bf2f(bf16_t h) { return __uint_as_float(((unsigned)h) << 16); }
DI unsigned cvt_pk_bf16(float lo, float hi) { unsigned r; asm volatile("v_cvt_pk_bf16_f32 %0, %1, %2" : "=v"(r) : "v"(lo), "v"(hi)); return r; }
DI float wave_sum(float v) {
#pragma unroll
    for (int o = 32; o > 0; o >>= 1) v += __shfl_xor(v, o);
    return v;
}
DI int otid() { int t = threadIdx.x; asm volatile("" : "+v"(t)); return t; }
DI float silu(float v) { return v * __builtin_amdgcn_rcpf(1.f + __builtin_amdgcn_exp2f(-1.4426950408889634f * v)); }

#define XB_TMO      128
#define XB_XCNT(j)  (256  + 64 * (j))
#define XB_XSUB(j)  (1280 + 64 * (j))
#define XB_XGEN(j)  (2304 + 64 * (j))
#define XB_TOP      3328
#define XB_TOPGEN   3392
#define XB_SPIN_CAP (1u << 22)
DI unsigned xb_ld(unsigned* p) { return __hip_atomic_load(p, __ATOMIC_RELAXED, __HIP_MEMORY_SCOPE_AGENT); }
DI unsigned xb_add(unsigned* p, unsigned v) { return __hip_atomic_fetch_add(p, v, __ATOMIC_RELAXED, __HIP_MEMORY_SCOPE_AGENT); }
DI unsigned xb_xcc_id() { return (unsigned)__builtin_amdgcn_s_getreg((3 << 11) | 20) & 0xFu; }
#define XB_SPIN(cond, bar) do { unsigned _sp = 0; while (cond) { __builtin_amdgcn_s_sleep(8); \
    if ((++_sp & 255u) == 0u) { if (xb_ld(&(bar)[XB_TMO])) break; if (_sp > XB_SPIN_CAP) { atomicAdd(&(bar)[XB_TMO], 1u); break; } } } } while (0)
struct XcdBarrier { unsigned* bar; unsigned x; volatile LAS unsigned* st; };
DI XcdBarrier xcd_barrier_post(unsigned* bar, volatile LAS unsigned* st) {
    XcdBarrier b; b.bar = bar; b.x = xb_xcc_id(); b.st = st;
    if (threadIdx.x == 0) (void)xb_add(&bar[XB_XCNT(b.x)], 1u);
    return b;
}
DI void xcd_barrier_complete(unsigned* bar, unsigned x, unsigned& nloc, unsigned& nx) {
    const unsigned G = gridDim.x;
    unsigned sum, cnt, mine, sp = 0u;
    for (;;) {
        sum = 0u; cnt = 0u; mine = 0u;
#pragma unroll
        for (unsigned j = 0; j < 16; ++j) { const unsigned c = xb_ld(&bar[XB_XCNT(j)]); sum += c; cnt += (c > 0u) ? 1u : 0u; mine = (j == x) ? c : mine; }
        if (sum == G) break;
        __builtin_amdgcn_s_sleep(1);
        if ((++sp & 255u) == 0u) { if (xb_ld(&bar[XB_TMO])) break; if (sp > XB_SPIN_CAP) { atomicAdd(&bar[XB_TMO], 1u); break; } }
    }
    nloc = mine > 0u ? mine : 1u; nx = cnt > 0u ? cnt : 1u;
}
DI void xcd_barrier(const XcdBarrier& b) {
    asm volatile("s_waitcnt vmcnt(0)" ::: "memory");
    __syncthreads();
    if (threadIdx.x == 0) {
        unsigned* bar = b.bar;
        __builtin_amdgcn_s_waitcnt(0);
        unsigned nloc = b.st[0], nx = b.st[1];
        if (nloc == 0u) { xcd_barrier_complete(bar, b.x, nloc, nx); b.st[0] = nloc; b.st[1] = nx; }
        const unsigned old = xb_add(&bar[XB_XSUB(b.x)], 1u);
        const unsigned gen = old / nloc;
        if (old + 1u == (gen + 1u) * nloc) {
            __builtin_amdgcn_fence(__ATOMIC_RELEASE, "agent");
            asm volatile("s_waitcnt vmcnt(0)" ::: "memory");
            const unsigned og = xb_add(&bar[XB_TOP], 1u);
            const unsigned tg = og / nx;
            if (og + 1u == (tg + 1u) * nx) xb_add(&bar[XB_TOPGEN], 1u);
            else XB_SPIN(xb_ld(&bar[XB_TOPGEN]) == tg, bar);
            __builtin_amdgcn_fence(__ATOMIC_ACQUIRE, "agent");
            xb_add(&bar[XB_XGEN(b.x)], 1u);
            asm volatile("s_waitcnt vmcnt(0)" ::: "memory");
        } else {
            XB_SPIN(xb_ld(&bar[XB_XGEN(b.x)]) == gen, bar);
            __builtin_amdgcn_fence(__ATOMIC_ACQUIRE, "agent");
            asm volatile("s_waitcnt vmcnt(0)" ::: "memory");
        }
    }
    __syncthreads();
}
DI int next_item(unsigned* ctr, volatile LAS int* slot) {
    __syncthreads();
    if (threadIdx.x == 0) *slot = (int)xb_add(ctr, 1u);
    __syncthreads();
    return *slot;
}

DI int next_item_xcd(unsigned* ctr0  , int xcc0, int per_q, volatile LAS int* slot) {
    __syncthreads();
    if (threadIdx.x == 0) {
        int res = -1;
        for (int qi = 0; qi < 8 && res < 0; ++qi) {
            const int xq = (xcc0 + qi) & 7; unsigned* c = ctr0 + 64 * xq;
            if (xb_ld(c) < (unsigned)per_q) { const int li = (int)xb_add(c, 1u); if (li < per_q) res = xq * per_q + li; }
        }
        *slot = res;
    }
    __syncthreads();
    return *slot;
}
constexpr int BM = 256, BK = 64, HALF = 128, HTB = HALF * BK * 2, NXCD = 8, WGM = 8;
DI int lds_byte(int r, int c) { const int st = (r >> 4) * 2 + (c >> 5), rr = r & 15, cc = c & 31, ob = rr * 64 + cc * 2; return st * 1024 + (ob ^ (((ob >> 9) & 1) << 5)); }
DI void stage_rc(int b, int& R, int& C) { const int st = b / 1024, sb = b % 1024, swz = sb ^ (((sb >> 9) & 1) << 5); R = (st >> 1) * 16 + swz / 64; C = (st & 1) * 32 + (swz % 64) / 2; }

struct Unit { int pm, pn, kq; };
struct Sched {
    int nM, nN, nwg, G, c, skip_ctx, split;
    DI void init(int nM_, int nN_, int skip, int split_ = 0) { nM = nM_; nN = nN_; nwg = nM * nN; G = gridDim.x; c = blockIdx.x; skip_ctx = skip; split = split_; }
    DI bool next(int i, Unit& u) const {
        const long L = (long)i * G + c;
        u.kq = -1;
        if (split && L >= nwg) {
            const int q = (int)(L - nwg); if (q >= 128) return false;
            const int cu = q >> 2; u.kq = q & 3; u.pm = (cu >> 3) * 9; u.pn = cu & 7; return true;
        }
        if (L >= nwg) return false;
        int wgid = (int)L; { const int q = nwg / NXCD, r = nwg % NXCD, xcd = wgid % NXCD, off = wgid / NXCD; wgid = (xcd < r ? xcd * (q + 1) : r * (q + 1) + (xcd - r) * q) + off; }
        const int nig = WGM * nN, gid = wgid / nig, fm = gid * WGM, gsz = (nM - fm) < WGM ? (nM - fm) : WGM;
        int pm = fm + ((wgid % nig) % gsz); u.pn = (wgid % nig) / gsz;
        if (skip_ctx) pm = (pm >> 3) * 9 + 1 + (pm & 7);
        u.pm = pm; return true;
    }
};

template <class Epi, bool PERMROWS = false>
DI void gemm_phase(LAS unsigned char* lds, const bf16_t* A, int lda, const bf16_t* Bt, int K, const Sched& S, const Epi& E) {
    int tid = threadIdx.x; asm volatile("" : "+v"(tid));
    const int wid = __builtin_amdgcn_readfirstlane(tid >> 6), lane = tid & 63, wr = wid >> 2, wc = wid & 3, fr = lane & 15, fq = lane >> 4;
    const int ntF = K / BK, ntQ = K / (4 * BK); const size_t qstep = (size_t)(K / 4) * 2;
    unsigned voffA[2], voffB[2];
#pragma unroll
    for (int i = 0; i < 2; ++i) { int R, C; stage_rc(tid * 16 + i * 8192, R, C); const int Ra = PERMROWS ? (((R >> 6) * 16 + (R & 15)) * 8 + ((R >> 4) & 3)) : R;
        voffA[i] = (unsigned)(Ra * lda + C) * 2u; voffB[i] = (unsigned)(R * K + C) * 2u; }
    const size_t kstep = (size_t)(BK * 2);
    const size_t hstepA = (size_t)(PERMROWS ? 4 : HALF) * lda * 2, hstepB = (size_t)HALF * K * 2;
    const size_t tstepA = (size_t)BM * lda * 2, tstepB = 2 * hstepB;
    const unsigned ldsw = (unsigned)wid * 1024u;
    const int aoff = lds_byte(wr * 64 + fr, fq * 8), boff = lds_byte(wc * 32 + fr, fq * 8);
#define G_SA(b, h) (((b) * 2 + (h)) * HTB)
#define G_SB(b, h) ((4 + (b) * 2 + (h)) * HTB)
#define G_STAGE(bufoff, gbase, voff) do { _Pragma("unroll") for (int _i = 0; _i < 2; ++_i) \
        __builtin_amdgcn_global_load_lds((const unsigned*)((const char*)(gbase) + (voff)[_i]), (LAS unsigned*)(lds + (bufoff) + ldsw + _i * 8192), 16, 0, 0); } while (0)
#define G_LDA(dst, b, h) do { _Pragma("unroll") for (int m = 0; m < 4; ++m) _Pragma("unroll") for (int k = 0; k < 2; ++k) dst[m][k] = *(const LAS bf16x8*)(lds + G_SA(b, h) + aoff + m * 2048 + k * 1024); } while (0)
#define G_LDB(dst, b, h) do { _Pragma("unroll") for (int n = 0; n < 2; ++n) _Pragma("unroll") for (int k = 0; k < 2; ++k) dst[n][k] = *(const LAS bf16x8*)(lds + G_SB(b, h) + boff + n * 2048 + k * 1024); } while (0)
#define G_MMA(ai, bj, At, Bt_) do { __builtin_amdgcn_s_setprio(1); _Pragma("unroll") for (int m = 0; m < 4; ++m) _Pragma("unroll") for (int n = 0; n < 2; ++n) _Pragma("unroll") for (int k = 0; k < 2; ++k) \
        acc[ai][bj][m][n] = __builtin_amdgcn_mfma_f32_16x16x32_bf16(Bt_[n][k], At[m][k], acc[ai][bj][m][n], 0, 0, 0); __builtin_amdgcn_s_setprio(0); } while (0)
#define G_WAIT_V(n) asm volatile("s_waitcnt vmcnt(" #n ")" ::: "memory")
#define G_WAIT_L(n) asm volatile("s_waitcnt lgkmcnt(" #n ")" ::: "memory")
#define G_BAR __builtin_amdgcn_s_barrier()
#define G_SCHED __builtin_amdgcn_sched_barrier(0)
    Unit cur, nxt; int ui = 0;
    if (!S.next(0, cur)) return;
    f32x4 acc[2][2][4][2];
#pragma unroll
    for (int a = 0; a < 2; ++a)
#pragma unroll
        for (int b = 0; b < 2; ++b)
#pragma unroll
            for (int m = 0; m < 4; ++m)
#pragma unroll
                for (int n = 0; n < 2; ++n) acc[a][b][m][n] = (f32x4){0.f, 0.f, 0.f, 0.f};
    bf16x8 At[4][2], B0[2][2], B1[2][2];
    const char* cA = (const char*)A + (size_t)cur.pm * tstepA + (cur.kq >= 0 ? cur.kq * qstep : 0); const char* cB = (const char*)Bt + (size_t)cur.pn * tstepB + (cur.kq >= 0 ? cur.kq * qstep : 0);
    int nt = cur.kq >= 0 ? ntQ : ntF;
    G_STAGE(G_SB(0, 0), cB, voffB); G_STAGE(G_SA(0, 0), cA, voffA); G_STAGE(G_SB(0, 1), cB + hstepB, voffB); G_STAGE(G_SA(0, 1), cA + hstepA, voffA);
    if (wr == 1) G_BAR;
    G_WAIT_V(4); G_BAR;
    G_STAGE(G_SB(1, 0), cB + kstep, voffB); G_STAGE(G_SA(1, 0), cA + kstep, voffA); G_STAGE(G_SB(1, 1), cB + hstepB + kstep, voffB);
    G_WAIT_V(6); G_BAR;
    for (;;) {
        const bool has_next = S.next(ui + 1, nxt);
        const char* nA = has_next ? (const char*)A + (size_t)nxt.pm * tstepA + (nxt.kq >= 0 ? nxt.kq * qstep : 0) : cA; const char* nB = has_next ? (const char*)Bt + (size_t)nxt.pn * tstepB + (nxt.kq >= 0 ? nxt.kq * qstep : 0) : cB;
        for (int t = 0; t < nt; t += 2) {
            const bool last = (t == nt - 2);
            const char* a1 = cA + (size_t)(t + 1) * kstep;
            const char* a2 = last ? nA : cA + (size_t)(t + 2) * kstep; const char* b2 = last ? nB : cB + (size_t)(t + 2) * kstep;
            const char* a3 = a2 + kstep; const char* b3 = b2 + kstep;
            G_LDB(B0, 0, 0); G_SCHED; G_LDA(At, 0, 0); G_STAGE(G_SA(1, 1), a1 + hstepA, voffA);
            G_WAIT_L(8); G_BAR; G_WAIT_L(0); G_MMA(0, 0, At, B0); G_BAR; G_SCHED;
            G_LDB(B1, 0, 1); G_STAGE(G_SB(0, 0), b2, voffB);
            G_BAR; G_WAIT_L(0); G_MMA(0, 1, At, B1); G_BAR;
            G_LDA(At, 0, 1); G_STAGE(G_SA(0, 0), a2, voffA);
            G_BAR; G_WAIT_L(0); G_MMA(1, 0, At, B0); G_BAR; G_SCHED;
            G_STAGE(G_SB(0, 1), b2 + hstepB, voffB);
            G_WAIT_V(6); G_BAR; G_MMA(1, 1, At, B1); G_BAR;
            G_LDB(B0, 1, 0); G_SCHED; G_LDA(At, 1, 0); G_STAGE(G_SA(0, 1), a2 + hstepA, voffA);
            G_WAIT_L(8); G_BAR; G_WAIT_L(0); G_MMA(0, 0, At, B0); G_BAR; G_SCHED;
            G_LDB(B1, 1, 1); G_STAGE(G_SB(1, 0), b3, voffB);
            G_BAR; G_WAIT_L(0); G_MMA(0, 1, At, B1); G_BAR;
            G_LDA(At, 1, 1); G_STAGE(G_SA(1, 0), a3, voffA);
            G_BAR; G_WAIT_L(0); G_MMA(1, 0, At, B0); G_BAR; G_SCHED;
            G_STAGE(G_SB(1, 1), b3 + hstepB, voffB);
            G_WAIT_V(6); G_BAR; G_MMA(1, 1, At, B1); G_BAR;
        }
        E(acc, cur, wr, wc, fr, fq);
        if (!has_next) break;
#pragma unroll
        for (int a = 0; a < 2; ++a)
#pragma unroll
            for (int b = 0; b < 2; ++b)
#pragma unroll
                for (int m = 0; m < 4; ++m)
#pragma unroll
                    for (int n = 0; n < 2; ++n) acc[a][b][m][n] = (f32x4){0.f, 0.f, 0.f, 0.f};
        cur = nxt; cA = nA; cB = nB; ++ui; nt = cur.kq >= 0 ? ntQ : ntF;
    }
    G_WAIT_V(0);
    if (wr == 0) G_BAR;
    G_BAR;
#undef G_SA
#undef G_SB
#undef G_STAGE
#undef G_LDA
#undef G_LDB
#undef G_MMA
}

DI void st_bf16x4(bf16_t* p, f32x4 v) { u32x2 w; w.x = cvt_pk_bf16(v[0], v[1]); w.y = cvt_pk_bf16(v[2], v[3]); *(u32x2*)p = w; }
DI void rope4(f32x4& v0, f32x4& v1, const float* tab  ) {
    const f32x4 t0 = *(const f32x4*)tab, t1 = *(const f32x4*)(tab + 4);
    const float c[4] = {t0[0], t0[2], t1[0], t1[2]}, s[4] = {t0[1], t0[3], t1[1], t1[3]};
#pragma unroll
    for (int j = 0; j < 4; ++j) { const float a = v0[j], b = v1[j]; v0[j] = a * c[j] - b * s[j]; v1[j] = b * c[j] + a * s[j]; }
}

struct EpiInproj {
    unsigned char* ws;
    DI void operator()(const f32x4 (&acc)[2][2][4][2], const Unit& u, int wr, int wc, int fr, int fq) const {
        bf16_t* P = (bf16_t*)(ws + WS_P);
        const int b = u.pm / 9;
#pragma unroll
        for (int ai = 0; ai < 2; ++ai)
#pragma unroll
            for (int m = 0; m < 4; ++m) {
                const int row = u.pm * BM + ai * HALF + wr * 64 + m * 16 + fr;
                const int r = row - b * RB; const bool lat = r >= CL; const int t = r - CL;
#pragma unroll
                for (int bj = 0; bj < 2; ++bj) {
                    const int colg = u.pn * BM + bj * HALF + wc * 32;
                    f32x4 v0 = acc[ai][bj][m][0], v1 = acc[ai][bj][m][1];
                    const int c0 = colg + 4 * fq;
                    if (colg >= INW) continue;
                    if (colg >= C_NAV && colg < C_CQ) {
                        bf16_t* vt = (bf16_t*)(ws + WS_VTNA) + ((size_t)b * 768 + (c0 - C_NAV)) * RB + r;
#pragma unroll
                        for (int j = 0; j < 4; ++j) { vt[(size_t)j * RB] = f2bf(v0[j]); vt[(size_t)(16 + j) * RB] = f2bf(v1[j]); }
                    } else if (colg >= C_RV && colg < C_RG) {
                        bf16_t* vt = (bf16_t*)(ws + WS_VTR) + ((size_t)b * 640 + (c0 - C_RV)) * RB + r;
#pragma unroll
                        for (int j = 0; j < 4; ++j) { vt[(size_t)j * RB] = f2bf(v0[j]); vt[(size_t)(16 + j) * RB] = f2bf(v1[j]); }
                    } else if (colg >= C_KPE && colg < C_RQ) {
                        if (lat) rope4(v0, v1, (const float*)(ws + WS_TABM) + ((size_t)t * 32 + ((colg - C_KPE) >> 5) * 16 + 4 * fq) * 2);
                        bf16_t* kp = (bf16_t*)(ws + WS_KPE) + (size_t)row * 64 + (c0 - C_KPE);
                        st_bf16x4(kp, v0); st_bf16x4(kp + 16, v1);
                    } else if (colg >= C_RQ && colg < C_RV) {
                        if (lat) rope4(v0, v1, (const float*)(ws + WS_TABR) + ((size_t)t * 64 + (((colg - C_RQ) & 127) >> 5) * 16 + 4 * fq) * 2);
                        if (colg >= C_RK) {
                            v0 *= 0.08838834764831845f; v1 *= 0.08838834764831845f;
                            bf16_t* kt = (bf16_t*)(ws + WS_KTR) + ((size_t)b * 640 + (c0 - C_RK)) * RB + r;
#pragma unroll
                            for (int j = 0; j < 4; ++j) { kt[(size_t)j * RB] = f2bf(v0[j]); kt[(size_t)(16 + j) * RB] = f2bf(v1[j]); }
                        }
                        st_bf16x4(P + (size_t)row * INP + c0, v0); st_bf16x4(P + (size_t)row * INP + c0 + 16, v1);
                    } else {
                        if (colg >= C_CQ && colg < C_KPE) {
                            float ss = v0[0] * v0[0] + v0[1] * v0[1] + v0[2] * v0[2] + v0[3] * v0[3] + v1[0] * v1[0] + v1[1] * v1[1] + v1[2] * v1[2] + v1[3] * v1[3];
                            ss += __shfl_xor(ss, 16); ss += __shfl_xor(ss, 32);
                            if (fq == 0) ((float*)(ws + WS_SSQ))[(size_t)row * 32 + ((colg - C_CQ) >> 5)] = ss;
                        }
                        st_bf16x4(P + (size_t)row * INP + c0, v0); st_bf16x4(P + (size_t)row * INP + c0 + 16, v1);
                    }
                }
            }
    }
};

DI float row_rstd(const unsigned char* ws, int row, int which, int fq) {
    const f32x4 s4 = *(const f32x4*)((const float*)(ws + WS_SSQ) + (size_t)row * 32 + which * 16 + fq * 4);
    float ss = s4[0] + s4[1] + s4[2] + s4[3];
    ss += __shfl_xor(ss, 16); ss += __shfl_xor(ss, 32);
    return rsqrtf(ss * (1.f / 512.f) + 1e-6f);
}

struct EpiQup {
    unsigned char* ws;
    DI void operator()(const f32x4 (&acc)[2][2][4][2], const Unit& u, int wr, int wc, int fr, int fq) const {
        bf16_t* Q = (bf16_t*)(ws + WS_QM);
        const int b = u.pm / 9;
#pragma unroll
        for (int ai = 0; ai < 2; ++ai)
#pragma unroll
            for (int m = 0; m < 4; ++m) {
                const int row = u.pm * BM + ai * HALF + wr * 64 + m * 16 + fr;
                const int r = row - b * RB; const bool lat = r >= CL; const int t = r - CL;
                const float rs = row_rstd(ws, row, 0, fq);
#pragma unroll
                for (int bj = 0; bj < 2; ++bj) {
                    const int colg = u.pn * BM + bj * HALF + wc * 32;
                    if (colg >= 960) continue;
                    f32x4 v0 = acc[ai][bj][m][0] * rs, v1 = acc[ai][bj][m][1] * rs;
                    const int hc = colg % 192;
                    if (hc >= 128 && lat) rope4(v0, v1, (const float*)(ws + WS_TABM) + ((size_t)t * 32 + ((hc - 128) >> 5) * 16 + 4 * fq) * 2);
                    st_bf16x4(Q + (size_t)row * 960 + colg + 4 * fq, v0); st_bf16x4(Q + (size_t)row * 960 + colg + 4 * fq + 16, v1);
                }
            }
    }
};

struct EpiKVup {
    unsigned char* ws;
    DI void operator()(const f32x4 (&acc)[2][2][4][2], const Unit& u, int wr, int wc, int fr, int fq) const {
        bf16_t* Km = (bf16_t*)(ws + WS_KM);
        const int b = u.pm / 9, head = u.pn;
#pragma unroll
        for (int ai = 0; ai < 2; ++ai)
#pragma unroll
            for (int m = 0; m < 4; ++m) {
                const int row = u.pm * BM + ai * HALF + wr * 64 + m * 16 + fr;
                const int r = row - b * RB;
                const float rs = row_rstd(ws, row, 1, fq);
                {
                    const f32x4 v0 = acc[ai][0][m][0] * rs, v1 = acc[ai][0][m][1] * rs;
                    bf16_t* kp = Km + (size_t)row * 640 + head * 128 + wc * 32 + 4 * fq;
                    st_bf16x4(kp, v0); st_bf16x4(kp + 16, v1);
                }
                {
                    const f32x4 v0 = acc[ai][1][m][0] * rs, v1 = acc[ai][1][m][1] * rs;
                    bf16_t* vt = (bf16_t*)(ws + WS_VTM) + ((size_t)b * 640 + head * 128 + wc * 32 + 4 * fq) * RB + r;
#pragma unroll
                    for (int j = 0; j < 4; ++j) { vt[(size_t)j * RB] = f2bf(v0[j]); vt[(size_t)(16 + j) * RB] = f2bf(v1[j]); }
                }
            }
    }
};

struct EpiResid {
    unsigned char* ws; const float* gate;
    const float* pg; const float* pb;
    DI void operator()(const f32x4 (&acc)[2][2][4][2], const Unit& u, int wr, int wc, int fr, int fq) const {
        float* X = (float*)(ws + WS_X);
        const int b = u.pm / 9; const int s = (u.pm % 9 == 0) ? 4 : b;
        if (u.kq >= 0) {
            float* PT = (float*)(ws + WS_PART) + ((size_t)u.kq * 1024 + b * 256) * DM;
#pragma unroll
            for (int ai = 0; ai < 2; ++ai)
#pragma unroll
                for (int m = 0; m < 4; ++m)
#pragma unroll
                    for (int bj = 0; bj < 2; ++bj)
#pragma unroll
                        for (int n = 0; n < 2; ++n)
                            *(f32x4*)(PT + (size_t)(ai * HALF + wr * 64 + m * 16 + fr) * DM + u.pn * BM + bj * HALF + wc * 32 + n * 16 + 4 * fq) = acc[ai][bj][m][n];
            return;
        }
        const float* g = gate + (size_t)s * 12288;
        const float2* RS = (const float2*)(ws + WS_RSTAT);
#pragma unroll
        for (int ai = 0; ai < 2; ++ai)
#pragma unroll
            for (int m = 0; m < 4; ++m) {
                const int row = u.pm * BM + ai * HALF + wr * 64 + m * 16 + fr;
                float mu = 0.f, rs = 1.f;
                if (pg) { const float2 st = RS[row]; mu = st.x; rs = st.y; }
#pragma unroll
                for (int bj = 0; bj < 2; ++bj)
#pragma unroll
                    for (int n = 0; n < 2; ++n) {
                        const int col = u.pn * BM + bj * HALF + wc * 32 + n * 16 + 4 * fq;
                        float* xp = X + (size_t)row * DM + col;
                        f32x4 x4 = *(const f32x4*)xp; const f32x4 g4 = *(const f32x4*)(g + col);
                        if (pg) x4 = (x4 - mu) * rs * *(const f32x4*)(pg + col) + *(const f32x4*)(pb + col);
                        *(f32x4*)xp = x4 * ALPHA + g4 * acc[ai][bj][m][n];
                    }
            }
    }
};

struct EpiUp {
    unsigned char* ws;
    DI void operator()(const f32x4 (&acc)[2][2][4][2], const Unit& u, int wr, int wc, int fr, int fq) const {
        bf16_t* AU = (bf16_t*)(ws + WS_AU);
#pragma unroll
        for (int ai = 0; ai < 2; ++ai)
#pragma unroll
            for (int m = 0; m < 4; ++m) {
                const int row = u.pm * BM + ai * HALF + wr * 64 + m * 16 + fr;
#pragma unroll
                for (int bj = 0; bj < 2; ++bj)
#pragma unroll
                    for (int n = 0; n < 2; ++n) st_bf16x4(AU + (size_t)row * (2 * DFF) + u.pn * BM + bj * HALF + wc * 32 + n * 16 + 4 * fq, acc[ai][bj][m][n]);
            }
    }
};

struct EpiUpGlu {
    unsigned char* ws; const float* cw; const float* cb;
    DI void operator()(const f32x4 (&acc)[2][2][4][2], const Unit& u, int wr, int wc, int fr, int fq) const {
        bf16_t* G = (bf16_t*)(ws + WS_G);
        float* EA = (float*)(ws + WS_EDGE); float* EP = EA + (size_t)36 * 4 * DFF; float* EU = EP + (size_t)36 * 4 * DFF;
        const int tok0 = (wr * 16 + fr) * 8;
        const size_t row0 = (size_t)u.pm * BM + tok0;
        const bool e_lo = (fr == 0), e_hi = (fr == 15);
#pragma unroll
        for (int n = 0; n < 2; ++n) {
            const int col = u.pn * 128 + wc * 32 + n * 16 + 4 * fq;
            const f32x4 w0 = *(const f32x4*)(cw + col), w1 = *(const f32x4*)(cw + DFF + col), w2 = *(const f32x4*)(cw + 2 * DFF + col), bb = *(const f32x4*)(cb + col);
            f32x4 g[8];
            f32x4 ed_a, ed_p, ed_u;
#pragma unroll
            for (int j = 0; j < 4; ++j) {
                float a[8], uu[8];
#pragma unroll
                for (int k = 0; k < 8; ++k) { a[k] = acc[k >> 2][0][k & 3][n][j]; uu[k] = acc[k >> 2][1][k & 3][n][j]; }
                const float aprev = __shfl_up(a[7], 1), anext = __shfl_down(a[0], 1);
#pragma unroll
                for (int k = 0; k < 8; ++k) {
                    const float c = bb[j] + w0[j] * (k > 0 ? a[k - 1] : aprev) + w1[j] * a[k] + w2[j] * (k < 7 ? a[k + 1] : anext);
                    g[k][j] = silu(c) * uu[k];
                }
                if (e_lo) { ed_a[j] = a[0]; ed_p[j] = bb[j] + w1[j] * a[0] + w2[j] * a[1]; ed_u[j] = uu[0]; }
                if (e_hi) { ed_a[j] = a[7]; ed_p[j] = bb[j] + w0[j] * a[6] + w1[j] * a[7]; ed_u[j] = uu[7]; }
            }
#pragma unroll
            for (int k = 0; k < 8; ++k) {
                if ((k == 0 && e_lo) || (k == 7 && e_hi)) continue;
                st_bf16x4(G + (row0 + k) * DFF + col, g[k]);
            }
            if (e_lo || e_hi) {
                const size_t eo = ((size_t)u.pm * 4 + wr * 2 + (e_hi ? 1 : 0)) * DFF + col;
                *(f32x4*)(EA + eo) = ed_a; *(f32x4*)(EP + eo) = ed_p; *(f32x4*)(EU + eo) = ed_u;
            }
        }
    }
};

DI void conv_witem(const float* W, int K, int Nsrc, bf16_t* dst, const float* rowscale, bool perm_in, int kt, int ntile, int lane, bool glu_rows = false) {
    const int k0 = kt * 16, c0 = ntile * 256, n4 = lane * 4;
    const int cdst = c0 + n4;
    int csrc = cdst;
    if (perm_in && cdst >= C_RQ && cdst < C_RV) { const int pp = cdst & 63, g = pp >> 5, e = pp & 31; csrc = (cdst & ~63) + ((e < 16) ? g * 16 + e : 32 + g * 16 + (e - 16)); }
    const bool valid = csrc < Nsrc;
    const float* src = W + (size_t)k0 * Nsrc + csrc;
    f32x4 v[16];
#pragma unroll
    for (int i = 0; i < 16; ++i) v[i] = valid ? *(const f32x4*)(src + (size_t)i * Nsrc) : (f32x4){0.f, 0.f, 0.f, 0.f};
    if (rowscale) {
#pragma unroll
        for (int i = 0; i < 16; ++i) v[i] *= rowscale[k0 + i];
    }
    int drow = cdst;
    if (glu_rows) { const int hf = cdst >= DFF ? 1 : 0, jj = cdst - hf * DFF; drow = (jj >> 7) * 256 + hf * 128 + (jj & 127); }
    bf16_t* dp = dst + (size_t)drow * K + k0;
#pragma unroll
    for (int j = 0; j < 4; ++j) {
        u32x4 w0, w1;
        w0.x = cvt_pk_bf16(v[0][j], v[1][j]); w0.y = cvt_pk_bf16(v[2][j], v[3][j]); w0.z = cvt_pk_bf16(v[4][j], v[5][j]); w0.w = cvt_pk_bf16(v[6][j], v[7][j]);
        w1.x = cvt_pk_bf16(v[8][j], v[9][j]); w1.y = cvt_pk_bf16(v[10][j], v[11][j]); w1.z = cvt_pk_bf16(v[12][j], v[13][j]); w1.w = cvt_pk_bf16(v[14][j], v[15][j]);
        *(u32x4*)(dp + (size_t)j * K) = w0; *(u32x4*)(dp + (size_t)j * K + 8) = w1;
    }
}

DI void prep_items(const Params& p, LAS unsigned char* lds, int l, unsigned* ctr, int max_items) {
    const int tid = otid(), lane = tid & 63, wid = tid >> 6;
    LAS float* s_c = (LAS float*)lds;
    LAS float* s_red = (LAS float*)(lds + 40960);
    volatile LAS int* slot = (volatile LAS int*)(lds + LDS_CTRL + 64);
    constexpr int N_ADA = 48, PER_L = 12832, N_CONV = PER_L / 8;
    const int n_tab = (l == 0) ? 48 : 0;
    float* mod = (float*)(p.ws + WS_MOD);
    bool have_c = false;
    for (int done = 0; done < max_items; ++done) {
        const int it = next_item(ctr, slot);
        if (it >= N_ADA + n_tab + N_CONV) break;
        if (it < N_ADA) {
            if (!have_c) {
                for (int i = tid; i < 5 * 2048; i += 512) { const int s = i >> 11, k = i & 2047; const float v = s < 4 ? p.in[1][s * 2048 + k] : p.in[3][k]; s_c[i] = silu(v); }
                have_c = true;
                __syncthreads();
            }
            const int n0 = it * 256;
            const float* W = p.in[4] + (size_t)l * 2048 * 12288 + n0 + lane * 4;
            f32x4 a0 = (f32x4){0.f, 0.f, 0.f, 0.f}, a1 = a0, a2 = a0, a3 = a0, a4 = a0;
#pragma unroll 8
            for (int k = wid; k < 2048; k += 8) { const f32x4 w = *(const f32x4*)(W + (size_t)k * 12288); a0 += w * s_c[k]; a1 += w * s_c[2048 + k]; a2 += w * s_c[4096 + k]; a3 += w * s_c[6144 + k]; a4 += w * s_c[8192 + k]; }
            *(LAS f32x4*)(s_red + (wid * 5 + 0) * 256 + lane * 4) = a0; *(LAS f32x4*)(s_red + (wid * 5 + 1) * 256 + lane * 4) = a1; *(LAS f32x4*)(s_red + (wid * 5 + 2) * 256 + lane * 4) = a2;
            *(LAS f32x4*)(s_red + (wid * 5 + 3) * 256 + lane * 4) = a3; *(LAS f32x4*)(s_red + (wid * 5 + 4) * 256 + lane * 4) = a4;
            __syncthreads();
            for (int o = tid; o < 5 * 256; o += 512) { const int s = o >> 8, c = o & 255; float v = p.in[5][l * 12288 + n0 + c];
#pragma unroll
                for (int w = 0; w < 8; ++w) v += s_red[(w * 5 + s) * 256 + c];
                mod[(size_t)(l * 5 + s) * 12288 + n0 + c] = v; }
        } else if (it < N_ADA + n_tab) {
            const int e0 = (it - N_ADA) * 4096 + tid * 8;
#pragma unroll
            for (int i = 0; i < 8; ++i) {
                int e = e0 + i; float2* dst; int t, idx, nf;
                if (e < 65536) { dst = (float2*)(p.ws + WS_TABM) + e; t = e >> 5; idx = e & 31; nf = 16; }
                else { e -= 65536; dst = (float2*)(p.ws + WS_TABR) + e; t = e >> 6; idx = e & 63; nf = 32; }
                const int f = idx % nf; const float pos = (idx < nf) ? (float)(t >> 6) : (float)(t & 63);
                const float inv = exp2f(-(float)f * (13.287712379549449f / (float)nf));
                const float ang = pos * inv;
                float rev = ang * 0.15915494309189535f; rev -= floorf(rev);
                const float rr = rev * 6.283185307179586f;
                *dst = make_float2(__cosf(rr), __sinf(rr));
            }
        } else {
            int id = (it - N_ADA - n_tab) * 8 + wid;
            if (id < 3072) conv_witem(p.in[6] + (size_t)l * 2048 * INW, 2048, INW, (bf16_t*)(p.ws + WS_WIN) + (size_t)l * 6144 * 2048, nullptr, true, id % 128, id / 128, lane);
            else if ((id -= 3072) < 128) conv_witem(p.in[9] + (size_t)l * 512 * 960, 512, 960, (bf16_t*)(p.ws + WS_WUQ) + (size_t)l * 1024 * 512, p.in[7] + l * 512, false, id % 32, id / 32, lane);
            else if ((id -= 128) < 160) conv_witem(p.in[10] + (size_t)l * 512 * 1280, 512, 1280, (bf16_t*)(p.ws + WS_WUKV) + (size_t)l * 1280 * 512, p.in[8] + l * 512, false, id % 32, id / 32, lane);
            else if ((id -= 160) < 1024) conv_witem(p.in[13] + (size_t)l * 2048 * 2048, 2048, 2048, (bf16_t*)(p.ws + WS_WO) + (size_t)l * 2048 * 2048, nullptr, false, id % 128, id / 128, lane);
            else if ((id -= 1024) < 5632) conv_witem(p.in[16] + (size_t)l * 2048 * 11264, 2048, 11264, (bf16_t*)(p.ws + WS_WUP) + (size_t)l * 11264 * 2048, nullptr, false, id % 128, id / 128, lane, true);
            else { id -= 5632; conv_witem(p.in[19] + (size_t)l * 5632 * 2048, 5632, 2048, (bf16_t*)(p.ws + WS_WDN) + (size_t)l * 2048 * 5632, nullptr, false, id % 352, id / 352, lane); }
        }
    }
    __syncthreads();
}
DI void phase_prep(const Params& p, LAS unsigned char* lds) { prep_items(p, lds, 0, (unsigned*)(p.ws + WS_QCTR), 1 << 30); prep_items(p, lds, 1, (unsigned*)(p.ws + WS_QCTR + 256 * 5), 1 << 30); }
DI void deferred_prep(const Params& p, LAS unsigned char* lds, int max_items) { prep_items(p, lds, 1, (unsigned*)(p.ws + WS_QCTR + 256 * 5), max_items); }

DI void phase_init_x(const Params& p) {
    const int tid_ = otid(); const int lane = tid_ & 63, gw = blockIdx.x * 8 + (tid_ >> 6), nw = gridDim.x * 8;
    float* X = (float*)(p.ws + WS_X); bf16_t* H = (bf16_t*)(p.ws + WS_H); const float* mod = (const float*)(p.ws + WS_MOD);
    for (int row = gw; row < MR; row += nw) {
        const int b = row / RB, r = row % RB; const int s = r < CL ? 4 : b;
        const float* src = r < CL ? p.in[2] + ((size_t)b * CL + r) * DM : p.in[0] + ((size_t)b * TL + (r - CL)) * DM;
        const float* sh = mod + (size_t)s * 12288; const float* sc = sh + 2048;
#pragma unroll
        for (int i = 0; i < 8; ++i) {
            const int col = (i * 64 + lane) * 4;
            const f32x4 v = *(const f32x4*)(src + col);
            *(f32x4*)(X + (size_t)row * DM + col) = v;
            const f32x4 s4 = *(const f32x4*)(sh + col), c4 = *(const f32x4*)(sc + col);
            st_bf16x4(H + (size_t)row * DM + col, v * (c4 + 1.f) + s4);
        }
    }
}

DI void phase_ln(const Params& p, const float* gam, const float* bet, const float* modnext  , bool skip_ctx, bool final_out,
                 const float* cgate  , const float* pg, const float* pb  ) {
    const int tid_ = otid(); const int lane = tid_ & 63, gw = blockIdx.x * 8 + (tid_ >> 6), nw = gridDim.x * 8;
    float* X = (float*)(p.ws + WS_X); bf16_t* H = (bf16_t*)(p.ws + WS_H); float2* RS = (float2*)(p.ws + WS_RSTAT);
    for (int rowA = gw; rowA < MR; rowA += 2 * nw) {
        f32x4 v[2][8]; float sum[2] = {0.f, 0.f}; bool act[2]; int rows[2];
#pragma unroll
        for (int q = 0; q < 2; ++q) {
            const int row = rowA + q * nw; rows[q] = row;
            const int b = row / RB, r = row % RB;
            act[q] = row < MR && !(skip_ctx && r < CL);
            if (act[q]) {
                const bool cpart = cgate && r < CL;
                float pmu = 0.f, prs = 1.f;
                if (cpart && pg) { const float2 st = RS[row]; pmu = st.x; prs = st.y; }
#pragma unroll
                for (int i = 0; i < 8; ++i) {
                    const int col = (i * 64 + lane) * 4;
                    v[q][i] = *(const f32x4*)(X + (size_t)row * DM + col);
                    if (cpart) {
                        if (pg) v[q][i] = (v[q][i] - pmu) * prs * *(const f32x4*)(pg + col) + *(const f32x4*)(pb + col);
                        const float* pt = (const float*)(p.ws + WS_PART) + ((size_t)b * 256 + r) * DM + col;
                        const f32x4 ps = *(const f32x4*)pt + *(const f32x4*)(pt + (size_t)1024 * DM) + *(const f32x4*)(pt + (size_t)2048 * DM) + *(const f32x4*)(pt + (size_t)3072 * DM);
                        v[q][i] = v[q][i] * ALPHA + *(const f32x4*)(cgate + col) * ps;
                        *(f32x4*)(X + (size_t)row * DM + col) = v[q][i];
                    }
                }
            } else {
#pragma unroll
                for (int i = 0; i < 8; ++i) v[q][i] = (f32x4){0.f, 0.f, 0.f, 0.f};
            }
        }
#pragma unroll
        for (int q = 0; q < 2; ++q)
#pragma unroll
            for (int i = 0; i < 8; ++i) sum[q] += v[q][i][0] + v[q][i][1] + v[q][i][2] + v[q][i][3];
        float mu[2], sq[2] = {0.f, 0.f}, rs[2];
#pragma unroll
        for (int o = 32; o > 0; o >>= 1) { sum[0] += __shfl_xor(sum[0], o); sum[1] += __shfl_xor(sum[1], o); }
#pragma unroll
        for (int q = 0; q < 2; ++q) {
            mu[q] = sum[q] * (1.f / 2048.f);
#pragma unroll
            for (int i = 0; i < 8; ++i) { v[q][i] -= mu[q]; sq[q] += v[q][i][0] * v[q][i][0] + v[q][i][1] * v[q][i][1] + v[q][i][2] * v[q][i][2] + v[q][i][3] * v[q][i][3]; }
        }
#pragma unroll
        for (int o = 32; o > 0; o >>= 1) { sq[0] += __shfl_xor(sq[0], o); sq[1] += __shfl_xor(sq[1], o); }
#pragma unroll
        for (int q = 0; q < 2; ++q) {
            if (!act[q]) continue;
            rs[q] = rsqrtf(sq[q] * (1.f / 2048.f) + 1e-5f);
            const int row = rows[q]; const int b = row / RB, r = row % RB; const int s = r < CL ? 4 : b;
            if (lane == 0 && !final_out) RS[row] = make_float2(mu[q], rs[q]);
#pragma unroll
            for (int i = 0; i < 8; ++i) {
                const int col = (i * 64 + lane) * 4;
                const f32x4 o = v[q][i] * rs[q] * *(const f32x4*)(gam + col) + *(const f32x4*)(bet + col);
                if (final_out) { *(f32x4*)(p.out + ((size_t)b * TL + (r - CL)) * DM + col) = o; }
                else {
                    const f32x4 s4 = *(const f32x4*)(modnext + (size_t)s * 12288 + col), c4 = *(const f32x4*)(modnext + (size_t)s * 12288 + 2048 + col);
                    st_bf16x4(H + (size_t)row * DM + col, o * (c4 + 1.f) + s4);
                }
            }
        }
    }
}

DI void glu_fix_panel(const Params& p, int l, int pm) {
    unsigned char* ws = p.ws;
    bf16_t* G = (bf16_t*)(ws + WS_G);
    const float* EA = (const float*)(ws + WS_EDGE); const float* EP = EA + (size_t)36 * 4 * DFF; const float* EU = EP + (size_t)36 * 4 * DFF;
    const float* cw = p.in[17] + (size_t)l * 3 * DFF;
    const int tid_ = otid();
    const int pr = pm % 9;
    for (int it = tid_; it < 4 * (DFF / 4); it += 512) {
        const int col = (it % (DFF / 4)) * 4, e = it / (DFF / 4);
        f32x4 nb = (f32x4){0.f, 0.f, 0.f, 0.f}; int tap; int tok;
        if (e == 0) { tap = 0; tok = 0; if (!(pr == 0 || pr == 1)) nb = *(const f32x4*)(EA + ((size_t)(pm - 1) * 4 + 3) * DFF + col); }
        else if (e == 1) { tap = 2; tok = 127; nb = *(const f32x4*)(EA + ((size_t)pm * 4 + 2) * DFF + col); }
        else if (e == 2) { tap = 0; tok = 128; nb = *(const f32x4*)(EA + ((size_t)pm * 4 + 1) * DFF + col); }
        else { tap = 2; tok = 255; if (!(pr == 0 || pr == 8)) nb = *(const f32x4*)(EA + ((size_t)(pm + 1) * 4 + 0) * DFF + col); }
        const f32x4 w = *(const f32x4*)(cw + (size_t)tap * DFF + col);
        const size_t eo = ((size_t)pm * 4 + e) * DFF + col;
        const f32x4 pp = *(const f32x4*)(EP + eo), uu = *(const f32x4*)(EU + eo);
        f32x4 g;
#pragma unroll
        for (int j = 0; j < 4; ++j) g[j] = silu(pp[j] + w[j] * nb[j]) * uu[j];
        st_bf16x4(G + ((size_t)pm * BM + tok) * DFF + col, g);
    }
}

DI void mixer_item_naive(const Params& p, int l, int row, int slot, int lane) {
    const bf16_t* P = (const bf16_t*)(p.ws + WS_P);
    bf16_t* ymix = (bf16_t*)(p.ws + WS_YMIX);
    const int b = row / RB, r = row % RB; const bool lat = r >= CL; const size_t rowb = (size_t)b * RB;
    if (slot < 6) {
        const int h = slot;
        const bf16_t* qp = P + (size_t)row * INP + C_NAQ + h * 128;
        const float q0 = bf2f(qp[lane]), q1 = bf2f(qp[64 + lane]);
        const bf16_t* vt = (const bf16_t*)(p.ws + WS_VTNA) + ((size_t)b * 768 + h * 128) * RB;
        float m = -1e30f, ls = 0.f, o0 = 0.f, o1 = 0.f;
        const int t = r - CL, gr = t >> 6, gc = t & 63;
        const int r0 = min(max(gr - 4, 0), 24), cs = min(max(gc - 8, 0), 48);
        const float* rpb = p.in[11] + (size_t)(l * 6 + h) * 15 * 31;
        const int nk = lat ? 384 : 256;
        for (int kk = 0; kk < nk; ++kk) {
            int tok; float bias = 0.f;
            if (lat && kk < 128) { const int kr = kk >> 4, kc = kk & 15; tok = CL + (r0 + kr) * 64 + cs + kc; bias = rpb[(r0 + kr - gr + 7) * 31 + (cs + kc - gc + 15)]; }
            else tok = lat ? kk - 128 : kk;
            const bf16_t* kp = P + (rowb + tok) * INP + C_NAK + h * 128;
            float s = q0 * bf2f(kp[lane]) + q1 * bf2f(kp[64 + lane]);
            s = wave_sum(s) * 0.08838834764831845f + bias;
            const float mn = fmaxf(m, s), corr = __expf(m - mn), pp = __expf(s - mn);
            ls = ls * corr + pp;
            o0 = o0 * corr + pp * bf2f(vt[(size_t)lane * RB + tok]);
            o1 = o1 * corr + pp * bf2f(vt[(size_t)(64 + lane) * RB + tok]);
            m = mn;
        }
        const float inv = 1.f / ls;
        ymix[(size_t)row * DM + h * 128 + lane] = f2bf(o0 * inv); ymix[(size_t)row * DM + h * 128 + 64 + lane] = f2bf(o1 * inv);
    } else if (slot < 11) {
        const int h = slot - 6;
        const bf16_t* qp = (const bf16_t*)(p.ws + WS_QM) + (size_t)row * 960 + h * 192;
        const float q0 = bf2f(qp[lane]), q1 = bf2f(qp[64 + lane]), q2 = bf2f(qp[128 + lane]);
        const bf16_t* Km = (const bf16_t*)(p.ws + WS_KM); const bf16_t* Kpe = (const bf16_t*)(p.ws + WS_KPE);
        const bf16_t* vt = (const bf16_t*)(p.ws + WS_VTM) + ((size_t)b * 640 + h * 128) * RB;
        float m = -1e30f, ls = 0.f, o0 = 0.f, o1 = 0.f;
        const int nk = lat ? RB : CL;
        for (int n = 0; n < nk; ++n) {
            const bf16_t* kp = Km + (rowb + n) * 640 + h * 128;
            float s = q0 * bf2f(kp[lane]) + q1 * bf2f(kp[64 + lane]) + q2 * bf2f(Kpe[(rowb + n) * 64 + lane]);
            s = wave_sum(s) * 0.07216878364870322f;
            const float mn = fmaxf(m, s), corr = __expf(m - mn), pp = __expf(s - mn);
            ls = ls * corr + pp;
            o0 = o0 * corr + pp * bf2f(vt[(size_t)lane * RB + n]);
            o1 = o1 * corr + pp * bf2f(vt[(size_t)(64 + lane) * RB + n]);
            m = mn;
        }
        const float inv = 1.f / ls;
        ymix[(size_t)row * DM + 768 + h * 128 + lane] = f2bf(o0 * inv); ymix[(size_t)row * DM + 768 + h * 128 + 64 + lane] = f2bf(o1 * inv);
    } else {
        const int h = slot - 11;
        const float lgf = log1pf(-exp2f(p.in[12][(l * 2 + 0) * 5 + h])) * 1.4426950408889634f;
        const float lgb = log1pf(-exp2f(p.in[12][(l * 2 + 1) * 5 + h])) * 1.4426950408889634f;
        const bf16_t* qp = P + (size_t)row * INP + C_RQ + h * 128;
        const float q0 = bf2f(qp[lane]), q1 = bf2f(qp[64 + lane]);
        const bf16_t* vt = (const bf16_t*)(p.ws + WS_VTR) + ((size_t)b * 640 + h * 128) * RB;
        float o0 = 0.f, o1 = 0.f;
        const int nk = lat ? RB : CL; const int t = r - CL;
        for (int n = 0; n < nk; ++n) {
            const bf16_t* kp = P + (rowb + n) * INP + C_RK + h * 128;
            float s = wave_sum(q0 * bf2f(kp[lane]) + q1 * bf2f(kp[64 + lane]));
            float w;
            if (lat) {
                if (n < CL) w = exp2f(lgf * (float)(CL + t - n)) + exp2f(lgb * (float)(TL - t + n));
                else { const int mm = n - CL; w = (mm <= t ? exp2f(lgf * (float)(t - mm)) : 0.f) + (mm >= t ? exp2f(lgb * (float)(mm - t)) : 0.f); }
            } else w = (n <= r ? exp2f(lgf * (float)(r - n)) : 0.f) + (n >= r ? exp2f(lgb * (float)(n - r)) : 0.f);
            s *= w;
            o0 += s * bf2f(vt[(size_t)lane * RB + n]); o1 += s * bf2f(vt[(size_t)(64 + lane) * RB + n]);
        }
        const float mu = wave_sum(o0 + o1) * (1.f / 128.f);
        const float d0 = o0 - mu, d1 = o1 - mu;
        const float rs = rsqrtf(wave_sum(d0 * d0 + d1 * d1) * (1.f / 128.f) + 1e-5f);
        const bf16_t* gp = P + (size_t)row * INP + C_RG + h * 128;
        ymix[(size_t)row * DM + 1408 + h * 128 + lane] = f2bf(d0 * rs * silu(bf2f(gp[lane])));
        ymix[(size_t)row * DM + 1408 + h * 128 + 64 + lane] = f2bf(d1 * rs * silu(bf2f(gp[64 + lane])));
    }
}

#define MFMA16(a, b, c) __builtin_amdgcn_mfma_f32_16x16x32_bf16((a), (b), (c), 0, 0, 0)
DI float fast_exp2(float x) { return __builtin_amdgcn_exp2f(x); }
template <int DK>
DI void dense_attn_item(LAS unsigned char* lds, const bf16_t* Qb, int ldq, const bf16_t* Kb, int ldk, const bf16_t* Kpe, const bf16_t* Vt, int nkeys, float sl2, bf16_t* Ob) {
    const int tid = otid(), lane = tid & 63, wid = tid >> 6, r16 = lane & 15, q4 = lane >> 4;
    constexpr int KS = DK / 32, KCH = DK / 8, KROW = DK * 2 + 16, KTILE = 64 * KROW, VROW = 144, VTILE = 128 * VROW, NKL = (64 * KCH) / 512;
    bf16x8 qf[2][KS];
#pragma unroll
    for (int qg = 0; qg < 2; ++qg)
#pragma unroll
        for (int ks = 0; ks < KS; ++ks) qf[qg][ks] = *(const bf16x8*)(Qb + (size_t)(wid * 32 + qg * 16 + r16) * ldq + ks * 32 + q4 * 8);
    f32x4 oacc[2][8];
#pragma unroll
    for (int qg = 0; qg < 2; ++qg)
#pragma unroll
        for (int d = 0; d < 8; ++d) oacc[qg][d] = (f32x4){0.f, 0.f, 0.f, 0.f};
    float mrun[2] = {-1e30f, -1e30f}, lsum[2] = {0.f, 0.f};
    u32x4 kst[NKL], vst[2];
    const int ntiles = nkeys >> 6;
#define DA_LOAD(key0) do { \
        _Pragma("unroll") for (int i = 0; i < NKL; ++i) { const int cid = tid + i * 512, key = cid / KCH, cc = cid % KCH; \
            const bf16_t* src = (cc < 16) ? Kb + (size_t)((key0) + key) * ldk + cc * 8 : Kpe + (size_t)((key0) + key) * 64 + (cc - 16) * 8; kst[i] = *(const u32x4*)src; } \
        _Pragma("unroll") for (int i = 0; i < 2; ++i) { const int cid = tid + i * 512, dv = cid >> 3, cc = cid & 7; vst[i] = *(const u32x4*)(Vt + (size_t)dv * RB + (key0) + cc * 8); } } while (0)
#define DA_STORE(buf) do { \
        _Pragma("unroll") for (int i = 0; i < NKL; ++i) { const int cid = tid + i * 512, key = cid / KCH, cc = cid % KCH; *(LAS u32x4*)(lds + (buf) * KTILE + key * KROW + cc * 16) = kst[i]; } \
        _Pragma("unroll") for (int i = 0; i < 2; ++i) { const int cid = tid + i * 512, dv = cid >> 3, cc = cid & 7; *(LAS u32x4*)(lds + 2 * KTILE + (buf) * VTILE + dv * VROW + cc * 16) = vst[i]; } } while (0)
    DA_LOAD(0); DA_STORE(0);
    __syncthreads();
    for (int kt = 0; kt < ntiles; ++kt) {
        const int cur = kt & 1;
        if (kt + 1 < ntiles) DA_LOAD((kt + 1) * 64);
        const LAS unsigned char* kb_ = lds + cur * KTILE; const LAS unsigned char* vb_ = lds + 2 * KTILE + cur * VTILE;
#pragma unroll
        for (int kc = 0; kc < 2; ++kc) {
            f32x4 sacc[2][2];
#pragma unroll
            for (int kb = 0; kb < 2; ++kb) {
                sacc[0][kb] = (f32x4){0.f, 0.f, 0.f, 0.f}; sacc[1][kb] = (f32x4){0.f, 0.f, 0.f, 0.f};
#pragma unroll
                for (int kh = 0; kh < KS / 2; ++kh) {
                    const bf16x8 k0 = *(const LAS bf16x8*)(kb_ + ((2 * kc + kb) * 16 + r16) * KROW + (2 * kh) * 64 + q4 * 16);
                    const bf16x8 k1 = *(const LAS bf16x8*)(kb_ + ((2 * kc + kb) * 16 + r16) * KROW + (2 * kh + 1) * 64 + q4 * 16);
                    __builtin_amdgcn_s_setprio(1);
                    sacc[0][kb] = MFMA16(k0, qf[0][2 * kh], sacc[0][kb]); sacc[1][kb] = MFMA16(k0, qf[1][2 * kh], sacc[1][kb]);
                    sacc[0][kb] = MFMA16(k1, qf[0][2 * kh + 1], sacc[0][kb]); sacc[1][kb] = MFMA16(k1, qf[1][2 * kh + 1], sacc[1][kb]);
                    __builtin_amdgcn_s_setprio(0);
                }
            }
            bf16x8 pb[2];
#pragma unroll
            for (int qg = 0; qg < 2; ++qg) {
                float mx = fmaxf(fmaxf(fmaxf(sacc[qg][0][0], sacc[qg][0][1]), fmaxf(sacc[qg][0][2], sacc[qg][0][3])), fmaxf(fmaxf(sacc[qg][1][0], sacc[qg][1][1]), fmaxf(sacc[qg][1][2], sacc[qg][1][3])));
                mx = fmaxf(mx, __shfl_xor(mx, 16)); mx = fmaxf(mx, __shfl_xor(mx, 32));
                const float mnew = fmaxf(mrun[qg], mx * sl2), alpha = fast_exp2(mrun[qg] - mnew);
                mrun[qg] = mnew;
                float ps = 0.f;
#pragma unroll
                for (int kb = 0; kb < 2; ++kb)
#pragma unroll
                    for (int j = 0; j < 4; ++j) { const float pv = fast_exp2(sacc[qg][kb][j] * sl2 - mnew); sacc[qg][kb][j] = pv; ps += pv; }
                lsum[qg] = lsum[qg] * alpha + ps;
#pragma unroll
                for (int d = 0; d < 8; ++d) oacc[qg][d] *= alpha;
                u32x4 w; w.x = cvt_pk_bf16(sacc[qg][0][0], sacc[qg][0][1]); w.y = cvt_pk_bf16(sacc[qg][0][2], sacc[qg][0][3]);
                w.z = cvt_pk_bf16(sacc[qg][1][0], sacc[qg][1][1]); w.w = cvt_pk_bf16(sacc[qg][1][2], sacc[qg][1][3]);
                pb[qg] = __builtin_bit_cast(bf16x8, w);
            }
#pragma unroll
            for (int dh = 0; dh < 4; ++dh) {
                bf16x8 vfr[2];
#pragma unroll
                for (int d4 = 0; d4 < 2; ++d4) {
                    const int d = dh * 2 + d4;
                    const u32x2 lo = *(const LAS u32x2*)(vb_ + (d * 16 + r16) * VROW + (kc * 32 + q4 * 4) * 2);
                    const u32x2 hi = *(const LAS u32x2*)(vb_ + (d * 16 + r16) * VROW + (kc * 32 + 16 + q4 * 4) * 2);
                    u32x4 w; w.x = lo.x; w.y = lo.y; w.z = hi.x; w.w = hi.y;
                    vfr[d4] = __builtin_bit_cast(bf16x8, w);
                }
                __builtin_amdgcn_s_setprio(1);
#pragma unroll
                for (int d4 = 0; d4 < 2; ++d4) { const int d = dh * 2 + d4; oacc[0][d] = MFMA16(vfr[d4], pb[0], oacc[0][d]); oacc[1][d] = MFMA16(vfr[d4], pb[1], oacc[1][d]); }
                __builtin_amdgcn_s_setprio(0);
            }
        }
        if (kt + 1 < ntiles) DA_STORE(cur ^ 1);
        __syncthreads();
    }
#pragma unroll
    for (int qg = 0; qg < 2; ++qg) {
        float l = lsum[qg]; l += __shfl_xor(l, 16); l += __shfl_xor(l, 32);
        const float inv = 1.f / l;
        bf16_t* op = Ob + (size_t)(wid * 32 + qg * 16 + r16) * DM + q4 * 4;
#pragma unroll
        for (int d = 0; d < 8; ++d) st_bf16x4(op + d * 16, oacc[qg][d] * inv);
    }
#undef DA_LOAD
#undef DA_STORE
}

DI void phase_dense_attn(const Params& p, int l, LAS unsigned char* lds) {
    unsigned char* ws = p.ws;
    const bf16_t* P = (const bf16_t*)(ws + WS_P); bf16_t* ymix = (bf16_t*)(ws + WS_YMIX);
    const int n_lat = 4 * 5 * 8, n_ctx = (l == 0) ? (20 + 24) : 0;
    for (int it = blockIdx.x; it < n_lat + n_ctx; it += gridDim.x) {
        if (it < n_lat) {
            const int qb = it & 7, h = (it >> 3) % 5, b = it / 40; const size_t rowb = (size_t)b * RB, row0 = rowb + CL + qb * 256;
            dense_attn_item<192>(lds, (const bf16_t*)(ws + WS_QM) + row0 * 960 + h * 192, 960, (const bf16_t*)(ws + WS_KM) + rowb * 640 + h * 128, 640, (const bf16_t*)(ws + WS_KPE) + rowb * 64,
                                 (const bf16_t*)(ws + WS_VTM) + ((size_t)b * 640 + h * 128) * RB, RB, 0.07216878364870322f * 1.4426950408889634f, ymix + row0 * DM + 768 + h * 128);
        } else if (it < n_lat + 20) {
            const int i2 = it - n_lat, h = i2 % 5, b = i2 / 5; const size_t rowb = (size_t)b * RB;
            dense_attn_item<192>(lds, (const bf16_t*)(ws + WS_QM) + rowb * 960 + h * 192, 960, (const bf16_t*)(ws + WS_KM) + rowb * 640 + h * 128, 640, (const bf16_t*)(ws + WS_KPE) + rowb * 64,
                                 (const bf16_t*)(ws + WS_VTM) + ((size_t)b * 640 + h * 128) * RB, CL, 0.07216878364870322f * 1.4426950408889634f, ymix + rowb * DM + 768 + h * 128);
        } else {
            const int i2 = it - n_lat - 20, h = i2 % 6, b = i2 / 6; const size_t rowb = (size_t)b * RB;
            dense_attn_item<128>(lds, P + rowb * INP + C_NAQ + h * 128, INP, P + rowb * INP + C_NAK + h * 128, INP, nullptr,
                                 (const bf16_t*)(ws + WS_VTNA) + ((size_t)b * 768 + h * 128) * RB, CL, 0.08838834764831845f * 1.4426950408889634f, ymix + rowb * DM + h * 128);
        }
    }
}

DI bf16x8 scale_bf16x8(bf16x8 v, const float* w) {
    u32x4 o;
    o.x = cvt_pk_bf16(bf2f((bf16_t)v[0]) * w[0], bf2f((bf16_t)v[1]) * w[1]); o.y = cvt_pk_bf16(bf2f((bf16_t)v[2]) * w[2], bf2f((bf16_t)v[3]) * w[3]);
    o.z = cvt_pk_bf16(bf2f((bf16_t)v[4]) * w[4], bf2f((bf16_t)v[5]) * w[5]); o.w = cvt_pk_bf16(bf2f((bf16_t)v[6]) * w[6], bf2f((bf16_t)v[7]) * w[7]);
    return __builtin_bit_cast(bf16x8, o);
}
DI bf16x8 scale1_bf16x8(bf16x8 v, float w) {
    u32x4 o;
    o.x = cvt_pk_bf16(bf2f((bf16_t)v[0]) * w, bf2f((bf16_t)v[1]) * w); o.y = cvt_pk_bf16(bf2f((bf16_t)v[2]) * w, bf2f((bf16_t)v[3]) * w);
    o.z = cvt_pk_bf16(bf2f((bf16_t)v[4]) * w, bf2f((bf16_t)v[5]) * w); o.w = cvt_pk_bf16(bf2f((bf16_t)v[6]) * w, bf2f((bf16_t)v[7]) * w);
    return __builtin_bit_cast(bf16x8, o);
}
DI float ret_lg2(const Params& p, int l, int dir, int h) { return log1pf(-exp2f(p.in[12][(l * 2 + dir) * 5 + h])) * 1.4426950408889634f; }

DI void phase_ret_scan(const Params& p, int l, LAS unsigned char* lds) {
    const int tid = otid(), lane = tid & 63, wid = tid >> 6, r16 = lane & 15, q4 = lane >> 4;
    unsigned char* ws = p.ws;
    volatile LAS int* slot = (volatile LAS int*)(lds + LDS_CTRL + 64);
    constexpr int VRS = RB * 2 + 16;
    const int xcc0 = (int)(xb_xcc_id() & 7u);
    unsigned* ctr0 = (unsigned*)(ws + WS_QCTR + 256 * (8 + 8 * l));
    {
      for (;;) {
        const int it = next_item_xcd(ctr0, xcc0, 40, slot);
        if (it < 0) break;
        const int dvb = it & 7, dir = (it >> 3) & 1, h = (it >> 4) % 5, b = it / 80, dkb = wid;
        {
            const bf16_t* vsrc = (const bf16_t*)(ws + WS_VTR) + ((size_t)b * 640 + h * 128 + dvb * 16) * RB;
            u32x4 t[9];
#pragma unroll
            for (int i = 0; i < 9; ++i) { const int cid = tid + i * 512, rr = cid / 288, cc = cid % 288; t[i] = *(const u32x4*)(vsrc + (size_t)rr * RB + cc * 8); }
#pragma unroll
            for (int i = 0; i < 9; ++i) { const int cid = tid + i * 512, rr = cid / 288, cc = cid % 288; *(LAS u32x4*)(lds + rr * VRS + cc * 16) = t[i]; }
        }
        const float lg = ret_lg2(p, l, dir, h), gL = exp2f(lg * 128.f);
        float wt[4][8];
#pragma unroll
        for (int ks = 0; ks < 4; ++ks)
#pragma unroll
            for (int e = 0; e < 8; ++e) { const int pp = ks * 32 + q4 * 8 + e; wt[ks][e] = exp2f(lg * (float)(dir == 0 ? 127 - pp : pp)); }
        const bf16_t* kt = (const bf16_t*)(ws + WS_KTR) + ((size_t)b * 640 + h * 128 + dkb * 16 + r16) * RB + q4 * 8;
        const LAS unsigned char* vl = lds + r16 * VRS + q4 * 16;
        bf16_t* sb = (bf16_t*)(ws + WS_S) + ((size_t)((b * 5 + h) * 2 + dir) * 18) * 16384 + (dvb * 16 + r16) * 128 + dkb * 16 + q4 * 4;
        f32x4 st = (f32x4){0.f, 0.f, 0.f, 0.f};
        bf16x8 ca[4];
        { const int c0 = dir == 0 ? 0 : 1;
#pragma unroll
          for (int ks = 0; ks < 4; ++ks) ca[ks] = *(const bf16x8*)(kt + c0 * 128 + ks * 32); }
        __syncthreads();
#pragma unroll 2
        for (int step = 0; step < 18; ++step) {
            const int c = dir == 0 ? step : (step < 2 ? 1 - step : 19 - step);
            const int sn = step < 17 ? step + 1 : 17;
            const int cn = dir == 0 ? sn : (sn < 2 ? 1 - sn : 19 - sn);
            bf16x8 na_[4];
#pragma unroll
            for (int ks = 0; ks < 4; ++ks) na_[ks] = *(const bf16x8*)(kt + cn * 128 + ks * 32);
            st_bf16x4(sb + (size_t)c * 16384, st);
            f32x4 u = (f32x4){0.f, 0.f, 0.f, 0.f};
#pragma unroll
            for (int ks = 0; ks < 4; ++ks) u = MFMA16(scale_bf16x8(ca[ks], wt[ks]), *(const LAS bf16x8*)(vl + (c * 128 + ks * 32) * 2), u);
            st = st * gL + u;
#pragma unroll
            for (int ks = 0; ks < 4; ++ks) ca[ks] = na_[ks];
        }
      }
    }
}

DI void ret_out_item(const Params& p, int l, int b, int h, int c, LAS unsigned char* lds) {
    const int tid = otid(), lane = tid & 63, wid = tid >> 6, r16 = lane & 15, q4 = lane >> 4;
    unsigned char* ws = p.ws;
    const bf16_t* P = (const bf16_t*)(ws + WS_P);
    const float lgf = ret_lg2(p, l, 0, h), lgb = ret_lg2(p, l, 1, h);
    const size_t rowb = (size_t)b * RB; const int tok0 = c * 128, tl = wid * 16 + r16;
    const size_t row = rowb + tok0 + tl;
    constexpr int RS = 272, MB = 128 * RS;
    {
        const bf16_t* Sf = (const bf16_t*)(ws + WS_S) + ((size_t)((b * 5 + h) * 2 + 0) * 18 + c) * 16384;
        const bf16_t* Sb = (const bf16_t*)(ws + WS_S) + ((size_t)((b * 5 + h) * 2 + 1) * 18 + c) * 16384;
        const bf16_t* Kc = P + (rowb + tok0) * INP + C_RK + h * 128;
        const bf16_t* Vc = (const bf16_t*)(ws + WS_VTR) + ((size_t)b * 640 + h * 128) * RB + tok0;
        u32x4 t0[4], t1[4], t2[4], t3[4];
#pragma unroll
        for (int i = 0; i < 4; ++i) {
            const int cid = tid + i * 512, rr = cid >> 4, cc = cid & 15;
            t0[i] = *(const u32x4*)(Sf + rr * 128 + cc * 8); t1[i] = *(const u32x4*)(Sb + rr * 128 + cc * 8);
            t2[i] = *(const u32x4*)(Kc + (size_t)rr * INP + cc * 8); t3[i] = *(const u32x4*)(Vc + (size_t)rr * RB + cc * 8);
        }
#pragma unroll
        for (int i = 0; i < 4; ++i) {
            const int cid = tid + i * 512, rr = cid >> 4, cc = cid & 15;
            *(LAS u32x4*)(lds + 0 * MB + rr * RS + cc * 16) = t0[i]; *(LAS u32x4*)(lds + 1 * MB + rr * RS + cc * 16) = t1[i];
            *(LAS u32x4*)(lds + 2 * MB + rr * RS + cc * 16) = t2[i]; *(LAS u32x4*)(lds + 3 * MB + rr * RS + cc * 16) = t3[i];
        }
    }
    bf16x8 qf[4], qff[4], qfb[4];
    const float qdf = exp2f(lgf * (float)(tl + 1)), qdb = exp2f(lgb * (float)(128 - tl));
#pragma unroll
    for (int ks = 0; ks < 4; ++ks) { qf[ks] = *(const bf16x8*)(P + row * INP + C_RQ + h * 128 + ks * 32 + q4 * 8); qff[ks] = scale1_bf16x8(qf[ks], qdf); qfb[ks] = scale1_bf16x8(qf[ks], qdb); }
    f32x4 oacc[8];
#pragma unroll
    for (int d = 0; d < 8; ++d) oacc[d] = (f32x4){0.f, 0.f, 0.f, 0.f};
    __syncthreads();
    const LAS unsigned char* sfp = lds + 0 * MB + r16 * RS + q4 * 16;
    const LAS unsigned char* sbp = lds + 1 * MB + r16 * RS + q4 * 16;
    const LAS unsigned char* kcp = lds + 2 * MB + r16 * RS + q4 * 16;
    const LAS unsigned char* vtp = lds + 3 * MB + r16 * RS + q4 * 8;
#pragma unroll
    for (int d = 0; d < 8; ++d)
#pragma unroll
        for (int ks = 0; ks < 4; ++ks) {
            oacc[d] = MFMA16(*(const LAS bf16x8*)(sfp + d * 16 * RS + ks * 64), qff[ks], oacc[d]);
            oacc[d] = MFMA16(*(const LAS bf16x8*)(sbp + d * 16 * RS + ks * 64), qfb[ks], oacc[d]);
        }
#pragma unroll
    for (int kc = 0; kc < 4; ++kc) {
        f32x4 s[2];
#pragma unroll
        for (int hf = 0; hf < 2; ++hf) {
            s[hf] = (f32x4){0.f, 0.f, 0.f, 0.f};
#pragma unroll
            for (int ks = 0; ks < 4; ++ks) s[hf] = MFMA16(*(const LAS bf16x8*)(kcp + (2 * kc + hf) * 16 * RS + ks * 64), qf[ks], s[hf]);
#pragma unroll
            for (int j = 0; j < 4; ++j) {
                const int m = (2 * kc + hf) * 16 + q4 * 4 + j, d = tl - m;
                const float w = (d >= 0 ? exp2f(lgf * (float)d) : 0.f) + (d <= 0 ? exp2f(-lgb * (float)d) : 0.f);
                s[hf][j] *= w;
            }
        }
        u32x4 w4; w4.x = cvt_pk_bf16(s[0][0], s[0][1]); w4.y = cvt_pk_bf16(s[0][2], s[0][3]); w4.z = cvt_pk_bf16(s[1][0], s[1][1]); w4.w = cvt_pk_bf16(s[1][2], s[1][3]);
        const bf16x8 pb = __builtin_bit_cast(bf16x8, w4);
#pragma unroll
        for (int d = 0; d < 8; ++d) {
            const u32x2 lo = *(const LAS u32x2*)(vtp + d * 16 * RS + kc * 64), hi = *(const LAS u32x2*)(vtp + d * 16 * RS + kc * 64 + 32);
            u32x4 a4; a4.x = lo.x; a4.y = lo.y; a4.z = hi.x; a4.w = hi.y;
            oacc[d] = MFMA16(__builtin_bit_cast(bf16x8, a4), pb, oacc[d]);
        }
    }
    float sum = 0.f;
#pragma unroll
    for (int d = 0; d < 8; ++d) sum += oacc[d][0] + oacc[d][1] + oacc[d][2] + oacc[d][3];
    sum += __shfl_xor(sum, 16); sum += __shfl_xor(sum, 32);
    const float mu = sum * (1.f / 128.f);
    float sq = 0.f;
#pragma unroll
    for (int d = 0; d < 8; ++d) { oacc[d] -= mu; sq += oacc[d][0] * oacc[d][0] + oacc[d][1] * oacc[d][1] + oacc[d][2] * oacc[d][2] + oacc[d][3] * oacc[d][3]; }
    sq += __shfl_xor(sq, 16); sq += __shfl_xor(sq, 32);
    const float rs = rsqrtf(sq * (1.f / 128.f) + 1e-5f);
    const bf16_t* gp = P + row * INP + C_RG + h * 128 + q4 * 4;
    bf16_t* op = (bf16_t*)(ws + WS_YMIX) + row * DM + 1408 + h * 128 + q4 * 4;
#pragma unroll
    for (int d = 0; d < 8; ++d) {
        const u32x2 g2 = *(const u32x2*)(gp + d * 16);
        f32x4 g; g[0] = __uint_as_float(g2.x << 16); g[1] = __uint_as_float(g2.x & 0xffff0000u); g[2] = __uint_as_float(g2.y << 16); g[3] = __uint_as_float(g2.y & 0xffff0000u);
        f32x4 y;
#pragma unroll
        for (int j = 0; j < 4; ++j) y[j] = oacc[d][j] * rs * silu(g[j]);
        st_bf16x4(op + d * 16, y);
    }
}


DI void na_item(const Params& p, int l, int b, int h, int gr, int jq, int lane) {
    const int r16 = lane & 15, q4 = lane >> 4;
    unsigned char* ws = p.ws;
    const bf16_t* P = (const bf16_t*)(ws + WS_P);
    const int gc = jq * 16 + r16, r0 = min(max(gr - 4, 0), 24), band = min(max(jq * 16 - 8, 0), 32), cs = min(max(gc - 8, 0), 48);
    const size_t rowb = (size_t)b * RB, rowq = rowb + CL + gr * 64 + gc;
    const float sl2 = 0.08838834764831845f * 1.4426950408889634f;
    const float* rpb = p.in[11] + (size_t)(l * 6 + h) * 15 * 31;
    bf16x8 qf[4];
#pragma unroll
    for (int ks = 0; ks < 4; ++ks) qf[ks] = *(const bf16x8*)(P + rowq * INP + C_NAQ + h * 128 + ks * 32 + q4 * 8);
    f32x4 oacc[8];
#pragma unroll
    for (int d = 0; d < 8; ++d) oacc[d] = (f32x4){0.f, 0.f, 0.f, 0.f};
    float mrun = -1e30f, lsum = 0.f;
    const bf16_t* vtb = (const bf16_t*)(ws + WS_VTNA) + ((size_t)b * 768 + h * 128 + r16) * RB + q4 * 4;
    const bf16_t* kbase = P + (rowb + r16) * INP + C_NAK + h * 128 + q4 * 8;
    const int tb0 = CL + r0 * 64 + band;
    bf16x8 kf[2][4];
#pragma unroll
    for (int hf = 0; hf < 2; ++hf)
#pragma unroll
        for (int ks = 0; ks < 4; ++ks) kf[hf][ks] = *(const bf16x8*)(kbase + (size_t)(tb0 + hf * 16) * INP + ks * 32);
#pragma unroll 2
    for (int ch = 0; ch < 16; ++ch) {
        const int tokbase = ch < 8 ? tb0 + ch * 64 : (ch - 8) * 32;
        const int chn = ch < 15 ? ch + 1 : 15;
        const int tokn = chn < 8 ? tb0 + chn * 64 : (chn - 8) * 32;
        u32x2 vlo[8], vhi[8];
#pragma unroll
        for (int d = 0; d < 8; ++d) { vlo[d] = *(const u32x2*)(vtb + (size_t)(d * 16) * RB + tokbase); vhi[d] = *(const u32x2*)(vtb + (size_t)(d * 16) * RB + tokbase + 16); }
        bf16x8 kn[2][4];
#pragma unroll
        for (int hf = 0; hf < 2; ++hf)
#pragma unroll
            for (int ks = 0; ks < 4; ++ks) kn[hf][ks] = *(const bf16x8*)(kbase + (size_t)(tokn + hf * 16) * INP + ks * 32);
        f32x4 s[2];
#pragma unroll
        for (int hf = 0; hf < 2; ++hf) {
            s[hf] = (f32x4){0.f, 0.f, 0.f, 0.f};
#pragma unroll
            for (int ks = 0; ks < 4; ++ks) s[hf] = MFMA16(kf[hf][ks], qf[ks], s[hf]);
        }
        if (ch < 8) {
            const float* rp = rpb + (r0 + ch - gr + 7) * 31;
#pragma unroll
            for (int hf = 0; hf < 2; ++hf)
#pragma unroll
                for (int j = 0; j < 4; ++j) {
                    const int kcol = band + hf * 16 + q4 * 4 + j; const bool inw = kcol >= cs && kcol < cs + 16;
                    const float bias = rp[min(max(kcol - gc + 15, 0), 30)];
                    s[hf][j] = inw ? s[hf][j] * sl2 + bias * 1.4426950408889634f : -1e30f;
                }
        } else { s[0] *= sl2; s[1] *= sl2; }
        float mx = fmaxf(fmaxf(fmaxf(s[0][0], s[0][1]), fmaxf(s[0][2], s[0][3])), fmaxf(fmaxf(s[1][0], s[1][1]), fmaxf(s[1][2], s[1][3])));
        mx = fmaxf(mx, __shfl_xor(mx, 16)); mx = fmaxf(mx, __shfl_xor(mx, 32));
        const float mnew = fmaxf(mrun, mx), alpha = fast_exp2(mrun - mnew);
        mrun = mnew;
        float ps = 0.f;
#pragma unroll
        for (int hf = 0; hf < 2; ++hf)
#pragma unroll
            for (int j = 0; j < 4; ++j) { const float pv = fast_exp2(s[hf][j] - mnew); s[hf][j] = pv; ps += pv; }
        lsum = lsum * alpha + ps;
#pragma unroll
        for (int d = 0; d < 8; ++d) oacc[d] *= alpha;
        u32x4 w4; w4.x = cvt_pk_bf16(s[0][0], s[0][1]); w4.y = cvt_pk_bf16(s[0][2], s[0][3]); w4.z = cvt_pk_bf16(s[1][0], s[1][1]); w4.w = cvt_pk_bf16(s[1][2], s[1][3]);
        const bf16x8 pb = __builtin_bit_cast(bf16x8, w4);
#pragma unroll
        for (int d = 0; d < 8; ++d) {
            u32x4 a4; a4.x = vlo[d].x; a4.y = vlo[d].y; a4.z = vhi[d].x; a4.w = vhi[d].y;
            oacc[d] = MFMA16(__builtin_bit_cast(bf16x8, a4), pb, oacc[d]);
        }
#pragma unroll
        for (int hf = 0; hf < 2; ++hf)
#pragma unroll
            for (int ks = 0; ks < 4; ++ks) kf[hf][ks] = kn[hf][ks];
    }
    float lt = lsum; lt += __shfl_xor(lt, 16); lt += __shfl_xor(lt, 32);
    const float inv = 1.f / lt;
    bf16_t* op = (bf16_t*)(ws + WS_YMIX) + rowq * DM + h * 128 + q4 * 4;
#pragma unroll
    for (int d = 0; d < 8; ++d) st_bf16x4(op + d * 16, oacc[d] * inv);
}

DI void na_block_item(const Params& p, int l, int b, int h, int rp, LAS unsigned char* lds) {
    const int tid = otid(), lane = tid & 63, wid = tid >> 6, r16 = lane & 15, q4 = lane >> 4;
    unsigned char* ws = p.ws;
    const bf16_t* P = (const bf16_t*)(ws + WS_P);
    constexpr int KROW = 272, KTILE = 64 * KROW, VROW = 144, VTILE = 128 * VROW;
    const int gr = 2 * rp + (wid >> 2), jq = wid & 3;
    const int gc = jq * 16 + r16, r0w = min(max(gr - 4, 0), 24), band = min(max(jq * 16 - 8, 0), 32), cs = min(max(gc - 8, 0), 48);
    const int r0a = min(max(2 * rp - 4, 0), 24), r0b = min(max(2 * rp - 3, 0), 24), nloc = r0b + 8 - r0a, ntl = nloc + 4;
    const size_t rowb = (size_t)b * RB, rowq = rowb + CL + gr * 64 + gc;
    const float sl2 = 0.08838834764831845f * 1.4426950408889634f;
    const float* rpb = p.in[11] + (size_t)(l * 6 + h) * 15 * 31;
    bf16x8 qf[4];
#pragma unroll
    for (int ks = 0; ks < 4; ++ks) qf[ks] = *(const bf16x8*)(P + rowq * INP + C_NAQ + h * 128 + ks * 32 + q4 * 8);
    f32x4 oacc[8];
#pragma unroll
    for (int d = 0; d < 8; ++d) oacc[d] = (f32x4){0.f, 0.f, 0.f, 0.f};
    float mrun = -1e30f, lsum = 0.f;
    const bf16_t* kg = P + rowb * INP + C_NAK + h * 128;
    const bf16_t* vg = (const bf16_t*)(ws + WS_VTNA) + ((size_t)b * 768 + h * 128) * RB;
    u32x4 kstA[2], vstA[2], kstB[2], vstB[2];
#define NA_TB(t) ((t) < nloc ? CL + (r0a + (t)) * 64 : ((t) - nloc) * 64)
#define NA_LOAD(t, ks_, vs_) do { const int tb_ = NA_TB(t); \
        _Pragma("unroll") for (int i = 0; i < 2; ++i) { const int cid = tid + i * 512; \
            ks_[i] = *(const u32x4*)(kg + (size_t)(tb_ + (cid >> 4)) * INP + (cid & 15) * 8); \
            vs_[i] = *(const u32x4*)(vg + (size_t)(cid >> 3) * RB + tb_ + (cid & 7) * 8); } } while (0)
#define NA_STORE(buf, ks_, vs_) do { \
        _Pragma("unroll") for (int i = 0; i < 2; ++i) { const int cid = tid + i * 512; \
            *(LAS u32x4*)(lds + (buf) * KTILE + (cid >> 4) * KROW + (cid & 15) * 16) = ks_[i]; \
            *(LAS u32x4*)(lds + 3 * KTILE + (buf) * VTILE + (cid >> 3) * VROW + (cid & 7) * 16) = vs_[i]; } } while (0)
    LAS float* s_rpb = (LAS float*)(lds + 3 * KTILE + 3 * VTILE);
    if (tid < 465) s_rpb[tid] = rpb[tid];
    NA_LOAD(0, kstA, vstA); NA_LOAD(1, kstB, vstB);
    NA_STORE(0, kstA, vstA);
    NA_LOAD(2, kstA, vstA);
    __syncthreads();
    for (int t = 0; t < ntl; ++t) {
        const int cur = t % 3;
        const bool local = t < nloc; const int kr = r0a + t;
        const int nch = local ? ((kr >= r0w && kr < r0w + 8) ? 1 : 0) : 2;
        for (int ci = 0; ci < nch; ++ci) {
            const int toff = local ? band : ci * 32;
            const LAS unsigned char* kb_ = lds + cur * KTILE + (toff + r16) * KROW + q4 * 16;
            const LAS unsigned char* vb_ = lds + 3 * KTILE + cur * VTILE + r16 * VROW + (toff + q4 * 4) * 2;
            float bias8[8];
            if (local) {
                const LAS float* rp_ = s_rpb + (kr - gr + 7) * 31;
#pragma unroll
                for (int e = 0; e < 8; ++e) { const int kcol = band + (e >> 2) * 16 + q4 * 4 + (e & 3); bias8[e] = rp_[min(max(kcol - gc + 15, 0), 30)]; }
            }
            f32x4 s[2];
#pragma unroll
            for (int hf = 0; hf < 2; ++hf) {
                s[hf] = (f32x4){0.f, 0.f, 0.f, 0.f};
#pragma unroll
                for (int ks = 0; ks < 4; ++ks) s[hf] = MFMA16(*(const LAS bf16x8*)(kb_ + hf * 16 * KROW + ks * 64), qf[ks], s[hf]);
            }
            if (local) {
#pragma unroll
                for (int hf = 0; hf < 2; ++hf)
#pragma unroll
                    for (int j = 0; j < 4; ++j) {
                        const int kcol = band + hf * 16 + q4 * 4 + j; const bool inw = kcol >= cs && kcol < cs + 16;
                        s[hf][j] = inw ? s[hf][j] * sl2 + bias8[hf * 4 + j] * 1.4426950408889634f : -1e30f;
                    }
            } else { s[0] *= sl2; s[1] *= sl2; }
            float mx = fmaxf(fmaxf(fmaxf(s[0][0], s[0][1]), fmaxf(s[0][2], s[0][3])), fmaxf(fmaxf(s[1][0], s[1][1]), fmaxf(s[1][2], s[1][3])));
            mx = fmaxf(mx, __shfl_xor(mx, 16)); mx = fmaxf(mx, __shfl_xor(mx, 32));
            const float mnew = fmaxf(mrun, mx), alpha = fast_exp2(mrun - mnew);
            mrun = mnew;
            float ps = 0.f;
#pragma unroll
            for (int hf = 0; hf < 2; ++hf)
#pragma unroll
                for (int j = 0; j < 4; ++j) { const float pv = fast_exp2(s[hf][j] - mnew); s[hf][j] = pv; ps += pv; }
            lsum = lsum * alpha + ps;
#pragma unroll
            for (int d = 0; d < 8; ++d) oacc[d] *= alpha;
            u32x4 w4; w4.x = cvt_pk_bf16(s[0][0], s[0][1]); w4.y = cvt_pk_bf16(s[0][2], s[0][3]); w4.z = cvt_pk_bf16(s[1][0], s[1][1]); w4.w = cvt_pk_bf16(s[1][2], s[1][3]);
            const bf16x8 pb = __builtin_bit_cast(bf16x8, w4);
            __builtin_amdgcn_s_setprio(1);
#pragma unroll
            for (int d = 0; d < 8; ++d) {
                const u32x2 lo = *(const LAS u32x2*)(vb_ + d * 16 * VROW), hi = *(const LAS u32x2*)(vb_ + d * 16 * VROW + 32);
                u32x4 a4; a4.x = lo.x; a4.y = lo.y; a4.z = hi.x; a4.w = hi.y;
                oacc[d] = MFMA16(__builtin_bit_cast(bf16x8, a4), pb, oacc[d]);
            }
            __builtin_amdgcn_s_setprio(0);
        }
        const int nb_ = (t + 1) % 3;
        if (t & 1) { if (t + 1 < ntl) NA_STORE(nb_, kstA, vstA); if (t + 3 < ntl) NA_LOAD(t + 3, kstA, vstA); }
        else       { if (t + 1 < ntl) NA_STORE(nb_, kstB, vstB); if (t + 3 < ntl) NA_LOAD(t + 3, kstB, vstB); }
        __syncthreads();
    }
#undef NA_TB
#undef NA_LOAD
#undef NA_STORE
    float lt = lsum; lt += __shfl_xor(lt, 16); lt += __shfl_xor(lt, 32);
    const float inv = 1.f / lt;
    bf16_t* op = (bf16_t*)(ws + WS_YMIX) + rowq * DM + h * 128 + q4 * 4;
#pragma unroll
    for (int d = 0; d < 8; ++d) st_bf16x4(op + d * 16, oacc[d] * inv);
}

DI void dense192_item(unsigned char* ws, LAS unsigned char* lds, int b, int h, int q0, int nk) {
    const size_t rowb = (size_t)b * RB, row0 = rowb + q0;
    dense_attn_item<192>(lds, (const bf16_t*)(ws + WS_QM) + row0 * 960 + h * 192, 960, (const bf16_t*)(ws + WS_KM) + rowb * 640 + h * 128, 640, (const bf16_t*)(ws + WS_KPE) + rowb * 64,
                         (const bf16_t*)(ws + WS_VTM) + ((size_t)b * 640 + h * 128) * RB, nk, 0.07216878364870322f * 1.4426950408889634f, (bf16_t*)(ws + WS_YMIX) + row0 * DM + 768 + h * 128);
}
DI void phase_mixers(const Params& p, int l, LAS unsigned char* lds) {
    unsigned char* ws = p.ws;
    volatile LAS int* slot = (volatile LAS int*)(lds + LDS_CTRL + 64);
    unsigned* ctr = (unsigned*)(ws + WS_QCTR + 256 * (1 + l));
    const int nc = (l == 0) ? 18 : 16, n_ro = 20 * nc, n_na = 384, n_ctx = (l == 0) ? 44 : 0;
    const int e0 = 160, e1 = e0 + n_ro, e2 = e1 + n_na, e3 = e2 + n_ctx;
    int it = next_item(ctr, slot);
    while (it < e0) { dense192_item(ws, lds, it / 40, (it >> 3) % 5, CL + (it & 7) * 256, RB); it = next_item(ctr, slot); }
    while (it < e1) { const int i2 = it - e0, c = (i2 % nc) + (18 - nc), bh = i2 / nc; ret_out_item(p, l, bh / 5, bh % 5, c, lds); it = next_item(ctr, slot); }
    while (it < e2) { const int i2 = it - e1; na_block_item(p, l, i2 / 96, (i2 >> 4) % 6, i2 & 15, lds); it = next_item(ctr, slot); }
    if (l == 0) {
        while (it < e2 + 20) { const int i2 = it - e2; dense192_item(ws, lds, i2 / 5, i2 % 5, 0, CL); it = next_item(ctr, slot); }
        while (it < e3) {
            const int i2 = it - e2 - 20, h = i2 % 6, b = i2 / 6; const size_t rowb = (size_t)b * RB;
            const bf16_t* P = (const bf16_t*)(ws + WS_P);
            dense_attn_item<128>(lds, P + rowb * INP + C_NAQ + h * 128, INP, P + rowb * INP + C_NAK + h * 128, INP, nullptr,
                                 (const bf16_t*)(ws + WS_VTNA) + ((size_t)b * 768 + h * 128) * RB, CL, 0.08838834764831845f * 1.4426950408889634f, (bf16_t*)(ws + WS_YMIX) + rowb * DM + h * 128);
            it = next_item(ctr, slot);
        }
    }
}

#define IN(k) (true)
#define SEAM(k) do { if ((k) != 19) xcd_barrier(bar); } while (0)
template <int L>
DI void layer_body(const Params& p, LAS unsigned char* lds, cg::grid_group& grid, const XcdBarrier& bar) {
        constexpr int l = L; constexpr int pb = 2 + 9 * l; constexpr bool last = (l == 1);
        unsigned char* ws = p.ws; asm volatile("" : "+s"(ws));
        const float* mod = (const float*)(ws + WS_MOD);
        if (IN(pb + 0)) {
            Sched S; S.init(36, 24, 0); EpiInproj E{ws};
            gemm_phase(lds, (const bf16_t*)(ws + WS_H), DM, (const bf16_t*)(ws + WS_WIN) + (size_t)l * 6144 * 2048, 2048, S, E);
            SEAM(pb + 0);
        }
        if (IN(pb + 1)) {
            { Sched S; S.init(36, 4, 0); EpiQup E{ws}; gemm_phase(lds, (const bf16_t*)(ws + WS_P) + C_CQ, INP, (const bf16_t*)(ws + WS_WUQ) + (size_t)l * 1024 * 512, 512, S, E); }
            { Sched S; S.init(36, 5, 0); EpiKVup E{ws}; gemm_phase(lds, (const bf16_t*)(ws + WS_P) + C_CKV, INP, (const bf16_t*)(ws + WS_WUKV) + (size_t)l * 1280 * 512, 512, S, E); }
            phase_ret_scan(p, l, lds);
            SEAM(pb + 1);
        }
        if (IN(pb + 2)) { phase_mixers(p, l, lds); SEAM(pb + 2); }
        if (IN(pb + 3)) {
            Sched S; S.init(32, 8, 1, last ? 0 : 1); EpiResid E{ws, mod + (size_t)(l * 5) * 12288 + 2 * 2048, l == 0 ? nullptr : p.in[20], l == 0 ? nullptr : p.in[21]};
            gemm_phase(lds, (const bf16_t*)(ws + WS_YMIX), DM, (const bf16_t*)(ws + WS_WO) + (size_t)l * 2048 * 2048, 2048, S, E);
            SEAM(pb + 3);
        }
        if (IN(pb + 4)) { phase_ln(p, p.in[14] + l * DM, p.in[15] + l * DM, mod + (size_t)(l * 5) * 12288 + 3 * 2048, last, false, last ? nullptr : mod + (size_t)(l * 5 + 4) * 12288 + 2 * 2048, nullptr, nullptr); SEAM(pb + 4); }
        if (IN(pb + 5)) {
            Sched S; S.init(last ? 32 : 36, 44, last); EpiUpGlu E{ws, p.in[17] + (size_t)l * 3 * DFF, p.in[18] + (size_t)l * DFF};
            gemm_phase<EpiUpGlu, true>(lds, (const bf16_t*)(ws + WS_H), DM, (const bf16_t*)(ws + WS_WUP) + (size_t)l * 11264 * 2048, 2048, S, E);
            SEAM(pb + 5);
        }
        if (IN(pb + 7)) {
            Sched S; S.init(32, 8, 1, last ? 0 : 1); EpiResid E{ws, mod + (size_t)(l * 5) * 12288 + 5 * 2048, p.in[14] + l * DM, p.in[15] + l * DM};
            { Unit u0; for (int i = 0; i < 2; ++i) if (S.next(i, u0)) glu_fix_panel(p, l, u0.pm);
              asm volatile("s_waitcnt vmcnt(0)" ::: "memory"); __syncthreads(); }
            gemm_phase(lds, (const bf16_t*)(ws + WS_G), DFF, (const bf16_t*)(ws + WS_WDN) + (size_t)l * 2048 * 5632, 5632, S, E);
            SEAM(pb + 7);
        }
        if (IN(pb + 8)) { phase_ln(p, p.in[20] + l * DM, p.in[21] + l * DM, mod + (size_t)((last ? 0 : l + 1) * 5) * 12288, last, last, last ? nullptr : mod + (size_t)(l * 5 + 4) * 12288 + 5 * 2048, p.in[14] + l * DM, p.in[15] + l * DM); SEAM(pb + 8); }
    }

__global__ void __launch_bounds__(512, 2) fwd_kernel(Params p) {
    extern __shared__ __attribute__((aligned(16))) unsigned char smem[];
    LAS unsigned char* lds = (LAS unsigned char*)smem;
    cg::grid_group grid = cg::this_grid();
    if (threadIdx.x < 32) ((volatile LAS unsigned*)(lds + LDS_CTRL))[threadIdx.x] = 0u;
    __syncthreads();
    const XcdBarrier bar = xcd_barrier_post((unsigned*)(p.ws + WS_CTL), (volatile LAS unsigned*)(lds + LDS_CTRL));
    if (p.ph_lo == 0x7fffffff) grid.sync();
    if (IN(0)) { phase_prep(p, lds); xcd_barrier(bar); }
    if (IN(1)) { phase_init_x(p); SEAM(1); }
    layer_body<0>(p, lds, grid, bar);
    layer_body<1>(p, lds, grid, bar);
}

extern "C" void kernel_launch(void* const* d_in, const int* in_sizes, int n_in, void* d_out, int out_size, void* d_ws, size_t ws_size, hipStream_t stream) {
    static int grid = 0;
    if (grid == 0) {
        if (n_in != 22 || ws_size < WS_END) { fprintf(stderr, "kernel_launch: need 22 inputs and %zu bytes of workspace (got %d, %zu)\n", (size_t)WS_END, n_in, ws_size); grid = -1; return; }
        int dev = 0, cus = 0, per_cu = 0;
        hipGetDevice(&dev); hipDeviceGetAttribute(&cus, hipDeviceAttributeMultiprocessorCount, dev);
        if (hipFuncSetAttribute((const void*)fwd_kernel, hipFuncAttributeMaxDynamicSharedMemorySize, LDS_BYTES) != hipSuccess) { fprintf(stderr, "kernel_launch: hipFuncSetAttribute failed\n"); grid = -1; return; }
        hipOccupancyMaxActiveBlocksPerMultiprocessor(&per_cu, (const void*)fwd_kernel, 512, LDS_BYTES);
        if (per_cu < 1) { fprintf(stderr, "kernel_launch: occupancy query says %d blocks per CU\n", per_cu); per_cu = 1; }
        grid = cus * 1;
        (void)hipGetLastError();
    }
    if (grid < 0) return;
    if (hipMemsetAsync((char*)d_ws + WS_CTL, 0, CTL_BYTES, stream) != hipSuccess) { fprintf(stderr, "kernel_launch: memset failed\n"); return; }
    Params p{};
    for (int i = 0; i < 22; ++i) p.in[i] = (const float*)d_in[i];
    p.out = (float*)d_out; p.ws = (unsigned char*)d_ws; p.ph_lo = 0; p.ph_hi = 20;
    void* args[] = {&p};
    hipError_t e = hipLaunchCooperativeKernel((const void*)fwd_kernel, dim3(grid), dim3(512), args, LDS_BYTES, stream);
    if (e != hipSuccess) fprintf(stderr, "cooperative launch failed: %s (grid %d)\n", hipGetErrorString(e), grid);
}
```
